# Optimizing an MI355X kernel written in HIP

```python
import math
import numpy as np
import jax
import jax.numpy as jnp
from jax import lax

D_MODEL = 1024
BATCH = 8
SEQ = 2048
DEPTH = 2

HEAD_DIM = 64
N_MIX_HEADS = 4
GROUP_W = N_MIX_HEADS * HEAD_DIM
MIX_W = 4 * GROUP_W
ROPE_THETA = 10000.0
EPS = 1e-6
Q_BLOCK = 128
NEG = -1e30
BIG = 1e9

DIL_PATTERNS = ((128, 1), (512, 4), (2048, 16))

MLA_Q_RANK = 256
MLA_KV_RANK = 128
MLA_NOPE = 64
MLA_ROPE = 32
MLA_V = 64

NSA_KV_DIM = 64
NSA_CMP_LEN = 32
NSA_CMP_STRIDE = 16
NSA_CMP_HID = 256
NSA_SEL_LEN = 64
NSA_N_SEL = 16
NSA_WINDOW = 512
SEL_Q_BLOCK = 64

IN_WIDTHS = (
    GROUP_W, GROUP_W, GROUP_W, GROUP_W,
    MLA_Q_RANK, MLA_KV_RANK, MLA_ROPE, GROUP_W,
    GROUP_W, NSA_KV_DIM, NSA_KV_DIM, NSA_KV_DIM, NSA_KV_DIM,
    NSA_KV_DIM, NSA_KV_DIM, 3 * N_MIX_HEADS, GROUP_W,
    GROUP_W, GROUP_W, GROUP_W, GROUP_W,
)
D_IN = sum(IN_WIDTHS)

kernel_name = "hybrid_parallel_heads_dilated_mla_nsa_stickbreak"


def rms_norm(x, g):
    xf = x.astype(jnp.float32)
    y = xf * lax.rsqrt(jnp.mean(xf * xf, axis=-1, keepdims=True) + EPS)
    return (y * g.astype(jnp.float32)).astype(x.dtype)


def rope(x, pos):
    half = x.shape[-1] // 2
    inv = ROPE_THETA ** (-jnp.arange(half, dtype=jnp.float32) / half)
    ang = pos.astype(jnp.float32)[:, None, :, None] * inv
    cos, sin = jnp.cos(ang), jnp.sin(ang)
    xf = x.astype(jnp.float32)
    x1, x2 = xf[..., :half], xf[..., half:]
    return jnp.concatenate([x1 * cos - x2 * sin, x1 * sin + x2 * cos], -1).astype(x.dtype)


def to_heads(t, n):
    b, s, _ = t.shape
    return t.reshape(b, s, n, -1).transpose(0, 2, 1, 3)


def from_heads(t):
    b, h, s, d = t.shape
    return t.transpose(0, 2, 1, 3).reshape(b, s, h * d)


def banded_attention(q, k, v, max_dist, block, scale):
    L = q.shape[-2]
    lead = q.shape[:-2]
    nb = -(-L // block)
    lp = nb * block
    n_prev = -(-max_dist // block)
    nz = [(0, 0)] * len(lead)
    qb = jnp.pad(q, nz + [(0, lp - L), (0, 0)]).reshape(*lead, nb, block, q.shape[-1])
    kr = jnp.pad(k, nz + [(n_prev * block, lp - L), (0, 0)]).reshape(*lead, nb + n_prev, block, k.shape[-1])
    vr = jnp.pad(v, nz + [(n_prev * block, lp - L), (0, 0)]).reshape(*lead, nb + n_prev, block, v.shape[-1])
    kb = jnp.concatenate([kr[..., o:o + nb, :, :] for o in range(n_prev + 1)], axis=-2)
    vb = jnp.concatenate([vr[..., o:o + nb, :, :] for o in range(n_prev + 1)], axis=-2)
    s = jnp.einsum('...nqd,...nkd->...nqk', qb, kb).astype(jnp.float32) * scale
    qpos = (jnp.arange(nb)[:, None] * block + jnp.arange(block)[None, :])[:, :, None]
    kpos = ((jnp.arange(nb)[:, None] - n_prev) * block
            + jnp.arange((n_prev + 1) * block)[None, :])[:, None, :]
    dist = qpos - kpos
    ok = (dist >= 0) & (dist <= max_dist) & (kpos >= 0)
    s = jnp.where(ok, s, NEG)
    m = jnp.max(s, axis=-1)
    p = jnp.where(ok, jnp.exp(s - m[..., None]), 0.0)
    l = jnp.sum(p, axis=-1)
    o = jnp.einsum('...nqk,...nkd->...nqd', p, vb.astype(jnp.float32)) / l[..., None]
    o = o.reshape(*lead, lp, v.shape[-1])[..., :L, :]
    return o, m.reshape(*lead, lp)[..., :L], l.reshape(*lead, lp)[..., :L]


def dilated_mixture_attention(q, k, v):
    b, h, s, d = q.shape
    outs, ms, ls = [], [], []
    for window, dil in DIL_PATTERNS:
        def regroup(t):
            return t.reshape(b, h, s // dil, dil, d).swapaxes(2, 3)
        o, m, l = banded_attention(regroup(q), regroup(k), regroup(v), window // dil, Q_BLOCK, d ** -0.5)
        outs.append(o.swapaxes(2, 3).reshape(b, h, s, d))
        ms.append(m.swapaxes(2, 3).reshape(b, h, s))
        ls.append(l.swapaxes(2, 3).reshape(b, h, s))
    m_all = jnp.stack(ms)
    wts = jnp.stack(ls) * jnp.exp(m_all - jnp.max(m_all, axis=0, keepdims=True))
    o = jnp.sum(wts[..., None] * jnp.stack(outs), axis=0) / jnp.sum(wts, axis=0)[..., None]
    return o.astype(q.dtype)


def blocked_causal_attention(q, k, v, scale):
    b, h, s, dq = q.shape
    nb = s // Q_BLOCK
    qb = q.reshape(b, h, nb, Q_BLOCK, dq).transpose(2, 0, 1, 3, 4)
    kpos = jnp.arange(s)

    def one(args):
        qi, blk = args
        sc = jnp.einsum('bhqd,bhkd->bhqk', qi, k).astype(jnp.float32) * scale
        qpos = blk * Q_BLOCK + jnp.arange(Q_BLOCK)
        sc = jnp.where(kpos[None, :] <= qpos[:, None], sc, NEG)
        p = jax.nn.softmax(sc, axis=-1)
        return jnp.einsum('bhqk,bhkd->bhqd', p, v.astype(jnp.float32))

    o = lax.map(one, (qb, jnp.arange(nb)))
    return o.transpose(1, 2, 0, 3, 4).reshape(b, h, s, v.shape[-1]).astype(q.dtype)


def mla_attention(c_q, c_kv, k_rope_in, pos, g_q, g_kv, w_uq, w_ukv):
    b, s, _ = c_q.shape
    q = to_heads(rms_norm(c_q, g_q) @ w_uq, N_MIX_HEADS)
    q = jnp.concatenate([q[..., :MLA_NOPE], rope(q[..., MLA_NOPE:], pos)], -1)
    kv = to_heads(rms_norm(c_kv, g_kv) @ w_ukv, N_MIX_HEADS)
    k_r = rope(k_rope_in[:, None], pos)
    k = jnp.concatenate([kv[..., :MLA_NOPE], jnp.broadcast_to(k_r, (b, N_MIX_HEADS, s, MLA_ROPE))], -1)
    v = kv[..., MLA_NOPE:]
    return blocked_causal_attention(q, k, v, (MLA_NOPE + MLA_ROPE) ** -0.5)


def compress_blocks(x, pos_emb, w1, w2):
    b, s, d = x.shape
    n = (s - NSA_CMP_LEN) // NSA_CMP_STRIDE + 1
    idx = jnp.arange(n)[:, None] * NSA_CMP_STRIDE + jnp.arange(NSA_CMP_LEN)[None, :]
    blocks = x[:, idx, :] + pos_emb
    return jax.nn.silu(blocks.reshape(b, n, NSA_CMP_LEN * d) @ w1) @ w2


def selected_block_attention(q, k, v, sel_idx, scale):
    b, h, s, d = q.shape
    n_top = sel_idx.shape[-1]
    kb = k.reshape(b, s // NSA_SEL_LEN, NSA_SEL_LEN, d)
    vb = v.reshape(b, s // NSA_SEL_LEN, NSA_SEL_LEN, d)
    nq = s // SEL_Q_BLOCK
    qb = q.reshape(b, h, nq, SEL_Q_BLOCK, d).transpose(2, 0, 1, 3, 4)
    ib = sel_idx.reshape(b, nq, SEL_Q_BLOCK, n_top).transpose(1, 0, 2, 3)
    gather = jax.vmap(lambda blocks, ix: blocks[ix])

    def one(args):
        qi, idx, blk = args
        kg = gather(kb, idx).reshape(b, SEL_Q_BLOCK, n_top * NSA_SEL_LEN, d)
        vg = gather(vb, idx).reshape(b, SEL_Q_BLOCK, n_top * NSA_SEL_LEN, d)
        kpos = (idx[..., None] * NSA_SEL_LEN + jnp.arange(NSA_SEL_LEN)).reshape(b, SEL_Q_BLOCK, -1)
        qpos = blk * SEL_Q_BLOCK + jnp.arange(SEL_Q_BLOCK)
        ok = kpos <= qpos[None, :, None]
        sc = jnp.einsum('bhqd,bqkd->bhqk', qi, kg).astype(jnp.float32) * scale
        p = jax.nn.softmax(jnp.where(ok[:, None], sc, NEG), axis=-1)
        return jnp.einsum('bhqk,bqkd->bhqd', p, vg.astype(jnp.float32))

    o = lax.map(one, (qb, ib, jnp.arange(nq)))
    return o.transpose(1, 2, 0, 3, 4).reshape(b, h, s, d)


def nsa_attention(q, k_cmp, v_cmp, k_slc, v_slc, k_win, v_win, gate_logits,
                  pos_k, pos_v, kw1, kw2, vw1, vw2):
    b, h, s, d = q.shape
    scale = d ** -0.5
    t = jnp.arange(s)
    kc = compress_blocks(k_cmp, pos_k, kw1, kw2)
    vc = compress_blocks(v_cmp, pos_v, vw1, vw2)
    n_cmp = kc.shape[1]
    cmp_ok = (jnp.arange(n_cmp) * NSA_CMP_STRIDE + NSA_CMP_LEN - 1)[None, :] <= t[:, None]
    sc = jnp.where(cmp_ok, jnp.einsum('bhtd,bnd->bhtn', q, kc).astype(jnp.float32) * scale, NEG)
    e = jnp.where(cmp_ok, jnp.exp(sc - jnp.max(sc, axis=-1, keepdims=True)), 0.0)
    den = jnp.sum(e, axis=-1, keepdims=True)
    p_cmp = e / jnp.maximum(den, 1e-30)
    o_cmp = jnp.einsum('bhtn,bnd->bhtd', p_cmp, vc.astype(jnp.float32))
    n_slc = s // NSA_SEL_LEN
    ci = jnp.arange(n_cmp)[:, None] * NSA_CMP_STRIDE
    sj = jnp.arange(n_slc)[None, :] * NSA_SEL_LEN
    overlap = ((ci < sj + NSA_SEL_LEN) & (ci + NSA_CMP_LEN > sj)).astype(jnp.float32)
    imp = jnp.einsum('bhtn,nj->btj', p_cmp, overlap)
    jj = jnp.arange(n_slc)[None, :]
    bt = (t // NSA_SEL_LEN)[:, None]
    forced = (jj == 0) | (jj == bt) | (jj == bt - 1)
    imp = jnp.where(forced, BIG, jnp.where(jj > bt, -BIG, imp))
    _, sel_idx = lax.top_k(imp, min(NSA_N_SEL, n_slc))
    o_slc = selected_block_attention(q, k_slc, v_slc, sel_idx, scale)
    kw = jnp.broadcast_to(k_win[:, None], (b, h, s, d))
    vw = jnp.broadcast_to(v_win[:, None], (b, h, s, d))
    o_win, _, _ = banded_attention(q, kw, vw, NSA_WINDOW - 1, Q_BLOCK, scale)
    g = jax.nn.sigmoid(gate_logits.astype(jnp.float32)).reshape(b, s, h, 3).transpose(0, 2, 1, 3)
    return (g[..., 0:1] * o_cmp + g[..., 1:2] * o_slc + g[..., 2:3] * o_win).astype(q.dtype)


def stick_breaking_attention(q, k, v):
    b, h, s, d = q.shape
    nb = s // Q_BLOCK
    qb = q.reshape(b, h, nb, Q_BLOCK, d).transpose(2, 0, 1, 3, 4)
    kpos = jnp.arange(s)

    def one(args):
        qi, blk = args
        z = jnp.einsum('bhqd,bhkd->bhqk', qi, k).astype(jnp.float32) * d ** -0.5
        qpos = blk * Q_BLOCK + jnp.arange(Q_BLOCK)
        strict = kpos[None, :] < qpos[:, None]
        log_keep = jnp.where(strict, jax.nn.log_sigmoid(-z), 0.0)
        rev = lax.cumsum(log_keep, axis=3, reverse=True)
        after = jnp.concatenate([rev[..., 1:], jnp.zeros_like(rev[..., :1])], axis=-1)
        a = jnp.where(strict, jnp.exp(jax.nn.log_sigmoid(z) + after), 0.0)
        return jnp.einsum('bhqk,bhkd->bhqd', a, v.astype(jnp.float32))

    o = lax.map(one, (qb, jnp.arange(nb)))
    return o.transpose(1, 2, 0, 3, 4).reshape(b, h, s, d).astype(q.dtype)


def hybrid_layer(x, pos, w_in, w_out, g_pre, g_post, mla_g_q, mla_g_kv, mla_w_uq, mla_w_ukv,
                 nsa_pos_k, nsa_pos_v, nsa_k_w1, nsa_k_w2, nsa_v_w1, nsa_v_w2):
    h = rms_norm(x, g_pre)
    proj = h @ w_in
    points = np.cumsum(IN_WIDTHS)[:-1].tolist()
    (a_q, a_k, a_v, a_g,
     b_cq, b_ckv, b_kr, b_g,
     c_q, c_kc, c_vc, c_ks, c_vs, c_kw, c_vw, c_gl, c_g,
     d_q, d_k, d_v, d_g) = jnp.split(proj, points, axis=-1)
    o_a = dilated_mixture_attention(rope(to_heads(a_q, N_MIX_HEADS), pos),
                                    rope(to_heads(a_k, N_MIX_HEADS), pos),
                                    to_heads(a_v, N_MIX_HEADS))
    o_b = mla_attention(b_cq, b_ckv, b_kr, pos, mla_g_q, mla_g_kv, mla_w_uq, mla_w_ukv)
    rope_k = lambda t: rope(t[:, None], pos)[:, 0]
    o_c = nsa_attention(rope(to_heads(c_q, N_MIX_HEADS), pos), rope_k(c_kc), c_vc, rope_k(c_ks), c_vs,
                        rope_k(c_kw), c_vw, c_gl, nsa_pos_k, nsa_pos_v,
                        nsa_k_w1, nsa_k_w2, nsa_v_w1, nsa_v_w2)
    o_d = stick_breaking_attention(to_heads(d_q, N_MIX_HEADS), to_heads(d_k, N_MIX_HEADS),
                                   to_heads(d_v, N_MIX_HEADS))
    mixed = jnp.concatenate([from_heads(o_a) * jax.nn.silu(a_g),
                             from_heads(o_b) * jax.nn.silu(b_g),
                             from_heads(o_c) * jax.nn.silu(c_g),
                             from_heads(o_d) * jax.nn.silu(d_g)], axis=-1).astype(x.dtype)
    return x + rms_norm(mixed @ w_out, g_post)


def setup_inputs(seed: int = 0) -> dict:
    key = jax.random.key(seed)
    ks = jax.random.split(key, 16)
    nrm = lambda k, shape, fan: jax.random.normal(k, shape, jnp.float32) * fan ** -0.5
    gain = lambda k, n: 1.0 + 0.05 * jax.random.normal(k, (DEPTH, n), jnp.float32)
    return {
        "x": jax.random.normal(ks[0], (BATCH, SEQ, D_MODEL), jnp.float32),
        "positions": jnp.broadcast_to(jnp.arange(SEQ, dtype=jnp.int32), (BATCH, SEQ)),
        "w_in": nrm(ks[1], (DEPTH, D_MODEL, D_IN), D_MODEL),
        "w_out": nrm(ks[2], (DEPTH, MIX_W, D_MODEL), MIX_W),
        "g_pre": gain(ks[3], D_MODEL),
        "g_post": gain(ks[4], D_MODEL),
        "mla_g_q": gain(ks[5], MLA_Q_RANK),
        "mla_g_kv": gain(ks[6], MLA_KV_RANK),
        "mla_w_uq": nrm(ks[7], (DEPTH, MLA_Q_RANK, N_MIX_HEADS * (MLA_NOPE + MLA_ROPE)), MLA_Q_RANK),
        "mla_w_ukv": nrm(ks[8], (DEPTH, MLA_KV_RANK, N_MIX_HEADS * (MLA_NOPE + MLA_V)), MLA_KV_RANK),
        "nsa_pos_k": 0.5 * jax.random.normal(ks[9], (DEPTH, NSA_CMP_LEN, NSA_KV_DIM), jnp.float32),
        "nsa_pos_v": 0.5 * jax.random.normal(ks[10], (DEPTH, NSA_CMP_LEN, NSA_KV_DIM), jnp.float32),
        "nsa_k_w1": nrm(ks[11], (DEPTH, NSA_CMP_LEN * NSA_KV_DIM, NSA_CMP_HID), NSA_CMP_LEN * NSA_KV_DIM),
        "nsa_k_w2": nrm(ks[12], (DEPTH, NSA_CMP_HID, NSA_KV_DIM), NSA_CMP_HID),
        "nsa_v_w1": nrm(ks[13], (DEPTH, NSA_CMP_LEN * NSA_KV_DIM, NSA_CMP_HID), NSA_CMP_LEN * NSA_KV_DIM),
        "nsa_v_w2": nrm(ks[14], (DEPTH, NSA_CMP_HID, NSA_KV_DIM), NSA_CMP_HID),
    }


def reference(x, positions, w_in, w_out, g_pre, g_post, mla_g_q, mla_g_kv, mla_w_uq, mla_w_ukv,
              nsa_pos_k, nsa_pos_v, nsa_k_w1, nsa_k_w2, nsa_v_w1, nsa_v_w2):
    for l in range(DEPTH):
        x = hybrid_layer(x, positions, w_in[l], w_out[l], g_pre[l], g_post[l],
                         mla_g_q[l], mla_g_kv[l], mla_w_uq[l], mla_w_ukv[l],
                         nsa_pos_k[l], nsa_pos_v[l], nsa_k_w1[l], nsa_k_w2[l],
                         nsa_v_w1[l], nsa_v_w2[l])
    return x
```

```cpp
#include <hip/hip_runtime.h>
#include <hip/hip_cooperative_groups.h>
#include <cstdio>
namespace cg = cooperative_groups;

typedef unsigned short u16;
typedef short bf16x8 __attribute__((ext_vector_type(8)));
typedef float f32x16 __attribute__((ext_vector_type(16)));
typedef __bf16 bf2_t __attribute__((ext_vector_type(2)));
typedef float f2_t __attribute__((ext_vector_type(2)));
typedef unsigned u32x4 __attribute__((ext_vector_type(4)));
typedef unsigned u32x2 __attribute__((ext_vector_type(2)));
typedef float f32x4 __attribute__((ext_vector_type(4)));

#define DI __device__ __forceinline__
#define MFMA32(a, b, c) __builtin_amdgcn_mfma_f32_32x32x16_bf16((a), (b), (c), 0, 0, 0)


constexpr int T_TOK = 16384, SEQ = 2048, DM = 1024, NP = 3712, NPW = 3840, NBATCH = 8;
constexpr int CA_Q = 0, CA_K = 256, CA_V = 512, CA_G = 768;
constexpr int CB_CQ = 1024, CB_CKV = 1280, CB_G = 1408;
constexpr int CC_Q = 1664, CC_KC = 1920, CC_VC = 1984, CC_KS = 2048, CC_VS = 2112, CC_KW = 2176, CC_VW = 2240, CC_G = 2304;
constexpr int CD_Q = 2560, CD_K = 2816, CD_V = 3072, CD_G = 3328;
constexpr int C_KR = 3584, C_GL = 3616;
constexpr float EPS = 1e-6f;
constexpr float NEGM = -3.0e38f;
constexpr float MINIT = -1.0e30f;

constexpr int SMEM_BYTES = 74752;
constexpr int L_IMPW = 36864, L_P3W = 53760, L_SELM = 70656, L_SELANY = 70784, L_JOB = 70788;

constexpr size_t al256(size_t x) { return (x + 255) & ~(size_t)255; }
constexpr size_t OFF_WINT = 0;
constexpr size_t OFF_WOUTT = OFF_WINT + al256((size_t)2 * NPW * 1024 * 2);
constexpr size_t OFF_WUQT = OFF_WOUTT + al256((size_t)2 * 1024 * 1024 * 2);
constexpr size_t OFF_WUKVT = OFF_WUQT + al256((size_t)2 * 384 * 256 * 2);
constexpr size_t OFF_W1T = OFF_WUKVT + al256((size_t)2 * 512 * 128 * 2);
constexpr size_t OFF_W2T = OFF_W1T + al256((size_t)4 * 256 * 2048 * 2);
constexpr size_t OFF_C64 = OFF_W2T + al256((size_t)4 * 64 * 256 * 2);
constexpr size_t OFF_S64 = OFF_C64 + al256((size_t)T_TOK * 32 * 4);
constexpr size_t OFF_C32 = OFF_S64 + al256((size_t)T_TOK * 32 * 4);
constexpr size_t OFF_S32 = OFF_C32 + al256((size_t)T_TOK * 16 * 4);
constexpr size_t OFF_XB = OFF_S32 + al256((size_t)T_TOK * 16 * 4);
constexpr size_t OFF_RSTD = OFF_XB + al256((size_t)T_TOK * 1024 * 2);
constexpr size_t OFF_PROJ = OFF_RSTD + al256((size_t)T_TOK * 4);
constexpr size_t OFF_QB = OFF_PROJ + al256((size_t)T_TOK * NP * 2);
constexpr size_t OFF_KB = OFF_QB + al256((size_t)T_TOK * 384 * 2);
constexpr size_t OFF_VB = OFF_KB + al256((size_t)T_TOK * 384 * 2);
constexpr size_t OFF_KC = OFF_VB + al256((size_t)T_TOK * 256 * 2);
constexpr size_t OFF_VC = OFF_KC + al256((size_t)NBATCH * 128 * 64 * 2);
constexpr size_t OFF_MIXED = OFF_VC + al256((size_t)NBATCH * 128 * 64 * 2);
constexpr size_t OFF_BAR = OFF_MIXED + al256((size_t)T_TOK * 1024 * 2);
constexpr size_t SYNC_BYTES = (size_t)3456 * 4 + 256 + 512 * 4;
constexpr size_t OFF_PART = OFF_BAR + al256(SYNC_BYTES);
constexpr size_t WS_TOTAL = OFF_PART + al256((size_t)4 * 128 * 4 * 128 * 4);

struct Params {
  const float *x, *w_in, *w_out, *g_pre, *g_post, *g_q, *g_kv, *w_uq, *w_ukv, *pos_k, *pos_v, *kw1, *kw2, *vw1, *vw2;
  const int* positions;
  float* out;
  char* ws;
  long long use_cg;
  DI u16* WinT() const { return (u16*)(ws + OFF_WINT); }
  DI u16* WoutT() const { return (u16*)(ws + OFF_WOUTT); }
  DI u16* WuqT() const { return (u16*)(ws + OFF_WUQT); }
  DI u16* WukvT() const { return (u16*)(ws + OFF_WUKVT); }
  DI u16* W1T() const { return (u16*)(ws + OFF_W1T); }
  DI u16* W2T() const { return (u16*)(ws + OFF_W2T); }
  DI float* c64() const { return (float*)(ws + OFF_C64); }
  DI float* s64() const { return (float*)(ws + OFF_S64); }
  DI float* c32() const { return (float*)(ws + OFF_C32); }
  DI float* s32() const { return (float*)(ws + OFF_S32); }
  DI u16* xb() const { return (u16*)(ws + OFF_XB); }
  DI u16* mixed() const { return (u16*)(ws + OFF_MIXED); }
  DI float* rstd() const { return (float*)(ws + OFF_RSTD); }
  DI u16* proj() const { return (u16*)(ws + OFF_PROJ); }
  DI u16* qB() const { return (u16*)(ws + OFF_QB); }
  DI u16* kB() const { return (u16*)(ws + OFF_KB); }
  DI u16* vB() const { return (u16*)(ws + OFF_VB); }
  DI u16* kc() const { return (u16*)(ws + OFF_KC); }
  DI u16* vc() const { return (u16*)(ws + OFF_VC); }
  DI unsigned* bar() const { return (unsigned*)(ws + OFF_BAR); }
  DI int* ctr() const { return (int*)(ws + OFF_BAR) + 3456; }
  DI unsigned* xcnt() const { return (unsigned*)(ws + OFF_BAR) + 3456 + 64; }
  DI float* xpart() const { return (float*)(ws + OFF_PART); }
};

DI unsigned pk2(float a, float b) {
  bf2_t r = __builtin_convertvector((f2_t){a, b}, bf2_t);
  return __builtin_bit_cast(unsigned, r);
}
DI float bflo(unsigned v) { return __uint_as_float(v << 16); }
DI float bfhi(unsigned v) { return __uint_as_float(v & 0xffff0000u); }
DI float bf2f(u16 v) { return __uint_as_float(((unsigned)v) << 16); }
DI u16 f2bf(float a) { return (u16)(pk2(a, 0.f) & 0xffffu); }
DI float sigmoidf_(float x) { return 1.0f / (1.0f + __expf(-x)); }
DI float siluf_(float x) { return x / (1.0f + __expf(-x)); }
DI bf16x8 pack8(float a0, float a1, float a2, float a3, float a4, float a5, float a6, float a7) {
  u32x4 u; u.x = pk2(a0, a1); u.y = pk2(a2, a3); u.z = pk2(a4, a5); u.w = pk2(a6, a7);
  return __builtin_bit_cast(bf16x8, u);
}
DI bf16x8 ld2x8(const u16* p0, const u16* p1) {
  const u32x2 a = *(const u32x2*)p0, b = *(const u32x2*)p1;
  u32x4 u; u.x = a.x; u.y = a.y; u.z = b.x; u.w = b.y;
  return __builtin_bit_cast(bf16x8, u);
}
DI Params relaunder(Params q) { asm volatile("" : "+s"(q.ws)); return q; }
DI int launder(int v) { asm volatile("" : "+v"(v)); return v; }
DI float xor32(float v) { return __shfl_xor(v, 32, 64); }


#define XB_TMO      128
#define XB_XCNT(j)  (256  + 64 * (j))
#define XB_XSUB(j)  (1280 + 64 * (j))
#define XB_XGEN(j)  (2304 + 64 * (j))
#define XB_TOP      3328
#define XB_TOPGEN   3392
#define XCD_BAR_WORDS 3456
#define XB_SPIN_CAP (1u << 20)
#define LAS __attribute__((address_space(3)))
DI unsigned xb_ld(unsigned* p) { return __hip_atomic_load(p, __ATOMIC_RELAXED, __HIP_MEMORY_SCOPE_AGENT); }
DI unsigned xb_add(unsigned* p, unsigned v) { return __hip_atomic_fetch_add(p, v, __ATOMIC_RELAXED, __HIP_MEMORY_SCOPE_AGENT); }
DI unsigned xb_xcc_id() { return (unsigned)__builtin_amdgcn_s_getreg((3 << 11) | 20) & 0xFu; }
#define XB_SPIN(cond, bar) do { unsigned _sp = 0; while (cond) { __builtin_amdgcn_s_sleep(1); \
    if ((++_sp & 255u) == 0u) { if (xb_ld(&(bar)[XB_TMO])) break; if (_sp > XB_SPIN_CAP) { atomicAdd(&(bar)[XB_TMO], 1u); break; } } } } while (0)
struct XcdBarrier { volatile LAS unsigned* st; };
DI XcdBarrier xcd_barrier_post(unsigned* bar, volatile LAS unsigned* st) {
  XcdBarrier b; b.st = st;
  if (threadIdx.x == 0) { const unsigned x = xb_xcc_id(); st[2] = x; (void)xb_add(&bar[XB_XCNT(x)], 1u); }
  return b;
}
DI void xcd_barrier_complete(unsigned* bar, unsigned x, unsigned& nloc, unsigned& nx) {
  const unsigned G = gridDim.x * gridDim.y * gridDim.z;
  unsigned sum, cnt, mine, sp = 0u;
  for (;;) {
    sum = 0u; cnt = 0u; mine = 0u;
#pragma unroll
    for (unsigned j = 0; j < 16; ++j) { const unsigned c = xb_ld(&bar[XB_XCNT(j)]); sum += c; cnt += (c > 0u) ? 1u : 0u; mine = (j == x) ? c : mine; }
    if (sum == G) break;
    __builtin_amdgcn_s_sleep(1);
    if ((++sp & 255u) == 0u) { if (xb_ld(&bar[XB_TMO])) break; if (sp > XB_SPIN_CAP) { atomicAdd(&bar[XB_TMO], 1u); break; } }
  }
  nloc = mine > 0u ? mine : 1u; nx = cnt > 0u ? cnt : 1u;
}
DI void xcd_barrier_(const XcdBarrier& b, unsigned* bar) {
  asm volatile("s_waitcnt vmcnt(0)" ::: "memory");
  __syncthreads();
  if (threadIdx.x == 0) {
    __builtin_amdgcn_s_waitcnt(0);
    unsigned nloc = b.st[0], nx = b.st[1];
    const unsigned bx = b.st[2];
    if (nloc == 0u) { xcd_barrier_complete(bar, bx, nloc, nx); b.st[0] = nloc; b.st[1] = nx; }
    const unsigned old = xb_add(&bar[XB_XSUB(bx)], 1u);
    const unsigned gen = old / nloc;
    if (old + 1u == (gen + 1u) * nloc) {
      __builtin_amdgcn_fence(__ATOMIC_RELEASE, "agent");
      asm volatile("s_waitcnt vmcnt(0)" ::: "memory");
      const unsigned og = xb_add(&bar[XB_TOP], 1u);
      const unsigned tg = og / nx;
      if (og + 1u == (tg + 1u) * nx) xb_add(&bar[XB_TOPGEN], 1u);
      else XB_SPIN(xb_ld(&bar[XB_TOPGEN]) == tg, bar);
      __builtin_amdgcn_fence(__ATOMIC_ACQUIRE, "agent");
      xb_add(&bar[XB_XGEN(bx)], 1u);
      asm volatile("s_waitcnt vmcnt(0)" ::: "memory");
    } else {
      XB_SPIN(xb_ld(&bar[XB_XGEN(bx)]) == gen, bar);
      __builtin_amdgcn_fence(__ATOMIC_ACQUIRE, "agent");
      asm volatile("s_waitcnt vmcnt(0)" ::: "memory");
    }
  }
  __syncthreads();
}

DI int inproj_colmap(int n) {
  if (n < 1408) return n;
  if (n < 2304) return n + 32;
  if (n < 3584) return n + 44;
  if (n < 3616) return 1408 + (n - 3584);
  if (n < 3628) return 2336 + (n - 3616);
  return -1;
}

template <bool INPROJ, bool FRAG>
DI void convT(u16* __restrict__ dst, const float* __restrict__ src, const float* __restrict__ rowscale, int K, int Nsrc,
              int Ndst, int gtid, int gsz) {
  const int kch = K >> 3;
  const int n4 = Ndst >> 2;
  const int total = n4 * kch;
  for (int idx = gtid; idx < total; idx += gsz) {
    const int n = (idx % n4) * 4, kc = idx / n4;
    const int sc = INPROJ ? inproj_colmap(n) : n;
    f32x4 v[8];
#pragma unroll
    for (int e = 0; e < 8; ++e) {
      const int k = kc * 8 + e;
      f32x4 w = {0.f, 0.f, 0.f, 0.f};
      if (sc >= 0) {
        w = *(const f32x4*)(src + (size_t)k * Nsrc + sc);
        if (rowscale) { const float rsn = rowscale[k]; w.x *= rsn; w.y *= rsn; w.z *= rsn; w.w *= rsn; }
      }
      v[e] = w;
    }
#pragma unroll
    for (int c = 0; c < 4; ++c) {
      u32x4 o;
      o.x = pk2(v[0][c], v[1][c]); o.y = pk2(v[2][c], v[3][c]); o.z = pk2(v[4][c], v[5][c]); o.w = pk2(v[6][c], v[7][c]);
      const int nn = n + c;
      if (FRAG) *(u32x4*)(dst + ((size_t)((nn >> 5) * (K >> 4) + (kc >> 1)) * 64 + (kc & 1) * 32 + (nn & 31)) * 8) = o;
      else *(u32x4*)(dst + (size_t)nn * K + kc * 8) = o;
    }
  }
}

DI void row_pre(const float* __restrict__ xr, u16* __restrict__ xbr, float* __restrict__ rstd_out, int lane) {
  float ss = 0.f;
#pragma unroll
  for (int c = 0; c < 4; ++c) {
    const f32x4 v = *(const f32x4*)(xr + c * 256 + lane * 4);
    ss += v.x * v.x + v.y * v.y + v.z * v.z + v.w * v.w;
    u32x2 o; o.x = pk2(v.x, v.y); o.y = pk2(v.z, v.w);
    *(u32x2*)(xbr + c * 256 + lane * 4) = o;
  }
#pragma unroll
  for (int off = 32; off >= 1; off >>= 1) ss += __shfl_xor(ss, off, 64);
  if (lane == 0) *rstd_out = rsqrtf(ss * (1.0f / 1024.0f) + EPS);
}

DI void conv_weights(const Params& p, int set, int gtid, int gsz) {
  for (int l = 0; l < 2; ++l) {
    if (set == 1) convT<false, true>(p.WoutT() + (size_t)l * 1024 * 1024, p.w_out + (size_t)l * 1024 * 1024, nullptr, 1024, 1024, 1024, gtid, gsz);
    if (l != set) continue;
    convT<true, true>(p.WinT() + (size_t)l * NPW * 1024, p.w_in + (size_t)l * 1024 * 3628, p.g_pre + l * 1024, 1024, 3628, NPW, gtid, gsz);
    convT<false, false>(p.WuqT() + (size_t)l * 384 * 256, p.w_uq + (size_t)l * 256 * 384, p.g_q + l * 256, 256, 384, 384, gtid, gsz);
    convT<false, false>(p.WukvT() + (size_t)l * 512 * 128, p.w_ukv + (size_t)l * 128 * 512, p.g_kv + l * 128, 128, 512, 512, gtid, gsz);
    convT<false, true>(p.W1T() + (size_t)(l * 2 + 0) * 256 * 2048, p.kw1 + (size_t)l * 2048 * 256, nullptr, 2048, 256, 256, gtid, gsz);
    convT<false, true>(p.W1T() + (size_t)(l * 2 + 1) * 256 * 2048, p.vw1 + (size_t)l * 2048 * 256, nullptr, 2048, 256, 256, gtid, gsz);
    convT<false, false>(p.W2T() + (size_t)(l * 2 + 0) * 64 * 256, p.kw2 + (size_t)l * 256 * 64, nullptr, 256, 64, 64, gtid, gsz);
    convT<false, false>(p.W2T() + (size_t)(l * 2 + 1) * 64 * 256, p.vw2 + (size_t)l * 256 * 64, nullptr, 256, 64, 64, gtid, gsz);
  }
}

DI void phase_init(const Params& p, int bid, int nb, int tid) {
  const int gtid = bid * 256 + tid, gsz = nb * 256;
  conv_weights(p, 0, gtid, gsz);
  for (int idx = gtid; idx < T_TOK * 48; idx += gsz) {
    const int t = idx / 48, i = idx % 48;
    const float posf = (float)p.positions[t];
    float inv;
    if (i < 32) inv = (float)exp2(-(double)i * (13.287712379549449 / 32.0));
    else inv = (float)exp2(-(double)(i - 32) * (13.287712379549449 / 16.0));
    const float ang = posf * inv;
    const float rev = ang * 0.15915494309189535f;
    const float fr = rev - floorf(rev);
    const float sn = __builtin_amdgcn_sinf(fr), cs = __builtin_amdgcn_cosf(fr);
    if (i < 32) ((unsigned*)p.c64())[t * 32 + i] = pk2(cs, sn);
    else { p.c32()[t * 16 + i - 32] = cs; p.s32()[t * 16 + i - 32] = sn; }
  }
  for (int idx = gtid; idx < NBATCH * 64; idx += gsz) {
    const int b = idx >> 6, d = idx & 63;
    p.kc()[(b * 128 + 127) * 64 + d] = 0;
    p.vc()[(b * 128 + 127) * 64 + d] = 0;
  }
  const int wave = tid >> 6, lane = tid & 63;
  for (int row = bid * 4 + wave; row < T_TOK; row += nb * 4)
    row_pre(p.x + (size_t)row * 1024, p.xb() + (size_t)row * 1024, p.rstd() + row, lane);
}

DI void store4(u16* dst, float a, float b, float c, float d) {
  u32x2 o; o.x = pk2(a, b); o.y = pk2(c, d);
  *(u32x2*)dst = o;
}

typedef __attribute__((address_space(1))) unsigned long long gu64;
DI void store4_wt(u16* dst, float a, float b, float c, float d) {
  const unsigned long long v = (unsigned long long)pk2(a, b) | ((unsigned long long)pk2(c, d) << 32);
  __hip_atomic_store((gu64*)dst, v, __ATOMIC_RELAXED, __HIP_MEMORY_SCOPE_AGENT);
}

DI void store8_pair(u16* dst, float a0, float a1, float a2, float a3, float b0, float b1, float b2, float b3, int h) {
  unsigned ax = pk2(a0, a1), ay = pk2(a2, a3), bx = pk2(b0, b1), by = pk2(b2, b3);
  auto rx = __builtin_amdgcn_permlane32_swap(ax, bx, false, false);
  auto ry = __builtin_amdgcn_permlane32_swap(ay, by, false, false);
  u32x4 o; o.x = rx[0]; o.y = ry[0]; o.z = rx[1]; o.w = ry[1];
  *(u32x4*)(dst + (h ? 8 : 0)) = o;
}

DI void load8_pair(const u16* src, int h, u32x2& ga, u32x2& gb) {
  const u32x4 v = *(const u32x4*)(src + (h ? 8 : 0));
  auto rx = __builtin_amdgcn_permlane32_swap(v.x, v.z, false, false);
  auto ry = __builtin_amdgcn_permlane32_swap(v.y, v.w, false, false);
  ga.x = rx[0]; ga.y = ry[0]; gb.x = rx[1]; gb.y = ry[1];
}

template <int MODE>
DI void gemm128(const Params& p, int l, int mt, int nt, unsigned char* smem, int tid) {
  const int lane = tid & 63, wave = tid >> 6, r31 = lane & 31, h = lane >> 5;
  const int wn = wave & 1, wt = wave >> 1;
  const int m0 = mt * 128, n0 = nt * 128;
  const u16* A; const u16* W; int lda, K;
  if (MODE == 0) { A = p.xb(); lda = 1024; K = 1024; W = p.WinT() + (size_t)l * NPW * 1024; }
  else if (MODE == 1) { A = p.proj() + CB_CQ; lda = NP; K = 256; W = p.WuqT() + (size_t)l * 384 * 256; }
  else if (MODE == 2) { A = p.proj() + CB_CKV; lda = NP; K = 128; W = p.WukvT() + (size_t)l * 512 * 128; }
  else { A = p.xb(); lda = 1024; K = 1024; W = p.WoutT() + (size_t)l * 1024 * 1024; }
  float* rs_s = (float*)(smem + 73728);

  __syncthreads();
  if (MODE == 1 || MODE == 2) {
    const int row = tid >> 1, half = tid & 1;
    const u16* ar = A + (size_t)(m0 + row) * lda + half * (K >> 1);
    float ss = 0.f;
    for (int c = 0; c < (K >> 4); ++c) {
      const u32x4 v = *(const u32x4*)(ar + c * 8);
      float f;
      f = bflo(v.x); ss += f * f; f = bfhi(v.x); ss += f * f;
      f = bflo(v.y); ss += f * f; f = bfhi(v.y); ss += f * f;
      f = bflo(v.z); ss += f * f; f = bfhi(v.z); ss += f * f;
      f = bflo(v.w); ss += f * f; f = bfhi(v.w); ss += f * f;
    }
    ss += __shfl_xor(ss, 1, 64);
    if (half == 0) rs_s[row] = rsqrtf(ss / (float)K + EPS);
  }

  f32x16 acc[2][2];
#pragma unroll
  for (int a = 0; a < 2; ++a)
#pragma unroll
    for (int b = 0; b < 2; ++b)
#pragma unroll
      for (int i = 0; i < 16; ++i) acc[a][b][i] = 0.f;

  const int KT = K >> 6;
  const int lrow = tid >> 3, lch = tid & 7;
  u32x4 xa[4], wa[4], xc[4], wc[4];
#define G_LOAD(XS, WS, KTI) { _Pragma("unroll") for (int rep = 0; rep < 4; ++rep) { \
      XS[rep] = *(const u32x4*)(A + (size_t)(m0 + lrow + rep * 32) * lda + (KTI) * 64 + lch * 8); \
      WS[rep] = *(const u32x4*)(W + (size_t)(n0 + lrow + rep * 32) * K + (KTI) * 64 + lch * 8); } }
#define G_STORE(XS, WS, BUF) { _Pragma("unroll") for (int rep = 0; rep < 4; ++rep) { \
      *(u32x4*)((u16*)(smem + (BUF) * 36864) + (lrow + rep * 32) * 72 + lch * 8) = XS[rep]; \
      *(u32x4*)((u16*)(smem + (BUF) * 36864 + 18432) + (lrow + rep * 32) * 72 + lch * 8) = WS[rep]; } }
#define G_COMPUTE(BUF) { const u16* Xb = (const u16*)(smem + (BUF) * 36864); const u16* Wb = (const u16*)(smem + (BUF) * 36864 + 18432); \
    _Pragma("unroll") for (int ks = 0; ks < 4; ++ks) { \
      bf16x8 wf[2], xf[2]; \
      _Pragma("unroll") for (int a = 0; a < 2; ++a) wf[a] = *(const bf16x8*)(Wb + (wn * 64 + a * 32 + r31) * 72 + ks * 16 + h * 8); \
      _Pragma("unroll") for (int b = 0; b < 2; ++b) xf[b] = *(const bf16x8*)(Xb + (wt * 64 + b * 32 + r31) * 72 + ks * 16 + h * 8); \
      _Pragma("unroll") for (int a = 0; a < 2; ++a) \
        _Pragma("unroll") for (int b = 0; b < 2; ++b) acc[a][b] = MFMA32(wf[a], xf[b], acc[a][b]); } }
  G_LOAD(xa, wa, 0);
  if (KT > 1) G_LOAD(xc, wc, 1);
  G_STORE(xa, wa, 0);
  __syncthreads();
  for (int kt = 0; kt < KT; kt += 2) {
    if (kt + 2 < KT) G_LOAD(xa, wa, kt + 2);
    G_COMPUTE(0);
    if (kt + 1 < KT) G_STORE(xc, wc, 1);
    __syncthreads();
    if (kt + 1 >= KT) break;
    if (kt + 3 < KT) G_LOAD(xc, wc, kt + 3);
    G_COMPUTE(1);
    if (kt + 2 < KT) G_STORE(xa, wa, 0);
    __syncthreads();
  }

  const int nbw = n0 + wn * 64;
#pragma unroll
  for (int b = 0; b < 2; ++b) {
    const int trow = wt * 64 + b * 32 + r31;
    const int tok = m0 + trow;
    if (MODE == 0) {
      const float rs = p.rstd()[tok];
      const bool rope = (nbw < 512) || (nbw >= 1664 && nbw < 1984) || (nbw == 2048) || (nbw == 2176);
      u16* dst = p.proj() + (size_t)tok * NP + nbw;
      if (rope) {
#pragma unroll
        for (int g = 0; g < 4; ++g) {
          const f32x4 cs = *(const f32x4*)(p.c64() + tok * 32 + 8 * g + 4 * h);
          const f32x4 sn = *(const f32x4*)(p.s64() + tok * 32 + 8 * g + 4 * h);
          const float x10 = acc[0][b][4 * g + 0] * rs, x11 = acc[0][b][4 * g + 1] * rs, x12 = acc[0][b][4 * g + 2] * rs, x13 = acc[0][b][4 * g + 3] * rs;
          const float x20 = acc[1][b][4 * g + 0] * rs, x21 = acc[1][b][4 * g + 1] * rs, x22 = acc[1][b][4 * g + 2] * rs, x23 = acc[1][b][4 * g + 3] * rs;
          store4(dst + 8 * g + 4 * h, x10 * cs.x - x20 * sn.x, x11 * cs.y - x21 * sn.y, x12 * cs.z - x22 * sn.z, x13 * cs.w - x23 * sn.w);
          store4(dst + 32 + 8 * g + 4 * h, x10 * sn.x + x20 * cs.x, x11 * sn.y + x21 * cs.y, x12 * sn.z + x22 * cs.z, x13 * sn.w + x23 * cs.w);
        }
      } else {
#pragma unroll
        for (int a = 0; a < 2; ++a)
#pragma unroll
          for (int g = 0; g < 4; ++g)
            store4(dst + a * 32 + 8 * g + 4 * h, acc[a][b][4 * g] * rs, acc[a][b][4 * g + 1] * rs, acc[a][b][4 * g + 2] * rs, acc[a][b][4 * g + 3] * rs);
      }
    } else if (MODE == 1) {
      const float rs = rs_s[trow];
#pragma unroll
      for (int a = 0; a < 2; ++a) {
        const int nsub = nbw + a * 32;
        u16* dst = p.qB() + (size_t)tok * 384 + nsub;
        float v[16];
#pragma unroll
        for (int i = 0; i < 16; ++i) v[i] = acc[a][b][i] * rs;
        if (((nsub >> 5) % 3) == 2) {
#pragma unroll
          for (int g = 0; g < 2; ++g) {
            const f32x4 cs = *(const f32x4*)(p.c32() + tok * 16 + 8 * g + 4 * h);
            const f32x4 sn = *(const f32x4*)(p.s32() + tok * 16 + 8 * g + 4 * h);
            const float c_[4] = {cs.x, cs.y, cs.z, cs.w};
            const float s_[4] = {sn.x, sn.y, sn.z, sn.w};
#pragma unroll
            for (int r = 0; r < 4; ++r) {
              const float x1 = v[4 * g + r], x2 = v[8 + 4 * g + r];
              v[4 * g + r] = x1 * c_[r] - x2 * s_[r];
              v[8 + 4 * g + r] = x1 * s_[r] + x2 * c_[r];
            }
          }
        }
#pragma unroll
        for (int gq = 0; gq < 2; ++gq) store8_pair(dst + 16 * gq, v[8 * gq], v[8 * gq + 1], v[8 * gq + 2], v[8 * gq + 3], v[8 * gq + 4], v[8 * gq + 5], v[8 * gq + 6], v[8 * gq + 7], h);
      }
    } else if (MODE == 2) {
      const float rs = rs_s[trow];
      const int head = nbw >> 7, part = (nbw >> 6) & 1;
      u16* dst = part ? (p.vB() + (size_t)tok * 256 + head * 64) : (p.kB() + (size_t)tok * 384 + head * 96);
#pragma unroll
      for (int a = 0; a < 2; ++a)
#pragma unroll
        for (int gq = 0; gq < 2; ++gq)
          store8_pair(dst + a * 32 + 16 * gq, acc[a][b][8 * gq] * rs, acc[a][b][8 * gq + 1] * rs, acc[a][b][8 * gq + 2] * rs, acc[a][b][8 * gq + 3] * rs,
                      acc[a][b][8 * gq + 4] * rs, acc[a][b][8 * gq + 5] * rs, acc[a][b][8 * gq + 6] * rs, acc[a][b][8 * gq + 7] * rs, h);
    } else {
      float* y = (float*)p.proj() + (size_t)tok * 1024 + nbw;
#pragma unroll
      for (int a = 0; a < 2; ++a)
#pragma unroll
        for (int g = 0; g < 4; ++g) {
          f32x4 o; o.x = acc[a][b][4 * g]; o.y = acc[a][b][4 * g + 1]; o.z = acc[a][b][4 * g + 2]; o.w = acc[a][b][4 * g + 3];
          *(f32x4*)(y + a * 32 + 8 * g + 4 * h) = o;
        }
    }
  }
}


DI void row_exchange(float* part_s, float* tot_s, float* pg  , unsigned* cntp, int nt, int tid) {
  __syncthreads();
  if (tid < 128) {
    const float t = (part_s[tid] + part_s[128 + tid]) + (part_s[256 + tid] + part_s[384 + tid]);
    __hip_atomic_store((unsigned*)(pg + nt * 128 + tid), __float_as_uint(t), __ATOMIC_RELAXED, __HIP_MEMORY_SCOPE_AGENT);
  }
  asm volatile("s_waitcnt vmcnt(0)" ::: "memory");
  __syncthreads();
  if (tid == 0) {
    (void)xb_add(cntp, 1u);
    unsigned sp = 0;
    while (xb_ld(cntp) < 4u) { __builtin_amdgcn_s_sleep(1); if (++sp > (1u << 22)) break; }
    __builtin_amdgcn_fence(__ATOMIC_ACQUIRE, "agent");
    asm volatile("s_waitcnt vmcnt(0)" ::: "memory");
  }
  __syncthreads();
  if (tid < 128) {
    float t[4];
#pragma unroll
    for (int q = 0; q < 4; ++q) t[q] = __uint_as_float(__hip_atomic_load((unsigned*)(pg + q * 128 + tid), __ATOMIC_RELAXED, __HIP_MEMORY_SCOPE_AGENT));
    tot_s[tid] = (t[0] + t[1]) + (t[2] + t[3]);
  }
  __syncthreads();
}

template <int MODE, int NB = 4>
DI void gemm_big(const Params& p, int l, int mt, int nt, unsigned char* smem, int tid, u32x4 (&xr)[NB], u32x4 (&wq)[8], bool pre, int nmt, int nnt) {
  const int lane = tid & 63, wave = tid >> 6, r31 = lane & 31, h = lane >> 5;
  const int m0 = mt * (NB * 32), n0 = nt * 256;
  const u16* A = (MODE == 0) ? p.xb() : p.mixed();
  const u16* W = (MODE == 0) ? (p.WinT() + (size_t)l * NPW * 1024) : (p.WoutT() + (size_t)l * 1024 * 1024);
  f32x16 acc[2][NB];
#pragma unroll
  for (int a = 0; a < 2; ++a)
#pragma unroll
    for (int b = 0; b < NB; ++b)
#pragma unroll
      for (int i = 0; i < 16; ++i) acc[a][b][i] = 0.f;
  const int lrow = tid >> 3, lch = tid & 7;
  const u16* Wf = W + ((size_t)((n0 >> 5) + wave * 2) * 64 * 64 + lane) * 8;
  const char* Abase = (const char*)(A + (size_t)m0 * 1024);
  const unsigned xoff = (unsigned)((lrow * 1024 + lch * 8) * 2);
#define GB_XLOAD(KTI) { _Pragma("unroll") for (int rep = 0; rep < NB; ++rep) xr[rep] = *(const u32x4*)(Abase + (size_t)(rep * 65536 + (KTI) * 128) + xoff); }
#define GB_XSTORE(BUF) { _Pragma("unroll") for (int rep = 0; rep < NB; ++rep) *(u32x4*)((u16*)(smem + (BUF) * 18432) + (lrow + rep * 32) * 72 + lch * 8) = xr[rep]; }
#define GB_WLD(A_, KS_, KTI) (*(const u32x4*)(Wf + (size_t)((A_) * 64 + (KTI) * 4 + (KS_)) * 512))
#define GB_XFRAG(XF, KS_) { _Pragma("unroll") for (int b = 0; b < NB; ++b) XF[b] = *(const bf16x8*)(Xb + (b * 32 + r31) * 72 + (KS_) * 16 + h * 8); }
#define GB_KS(XC, KS_, KTI) { \
    __builtin_amdgcn_s_setprio(2); \
    _Pragma("unroll") for (int a = 0; a < 2; ++a) { \
      _Pragma("unroll") for (int b = 0; b < NB; ++b) acc[a][b] = MFMA32(__builtin_bit_cast(bf16x8, wq[a * 4 + (KS_)]), XC[b], acc[a][b]); \
      if ((KTI) + 1 < 16) wq[a * 4 + (KS_)] = GB_WLD(a, (KS_), (KTI) + 1); } \
    __builtin_amdgcn_s_setprio(0); \
    __builtin_amdgcn_sched_barrier(0); }
#define GB_COMPUTE(BUF, KTI) { const u16* Xb = (const u16*)(smem + (BUF) * 18432); \
    bf16x8 xfa[NB], xfb[NB]; \
    GB_XFRAG(xfa, 0); GB_XFRAG(xfb, 1); GB_KS(xfa, 0, KTI); \
    GB_XFRAG(xfa, 2); GB_KS(xfb, 1, KTI); \
    GB_XFRAG(xfb, 3); GB_KS(xfa, 2, KTI); \
    GB_KS(xfb, 3, KTI); }
  __syncthreads();
  if (!pre) {
    GB_XLOAD(0);
#pragma unroll
    for (int a = 0; a < 2; ++a)
#pragma unroll
      for (int ks = 0; ks < 4; ++ks) wq[a * 4 + ks] = GB_WLD(a, ks, 0);
  }
  GB_XSTORE(0);
  GB_XLOAD(1);
  __syncthreads();
  for (int kt = 0; kt < 16; kt += 2) {
    GB_COMPUTE(0, kt);
    GB_XSTORE(1);
    if (kt + 2 < 16) GB_XLOAD(kt + 2);
    __syncthreads();
    GB_COMPUTE(1, kt + 1);
    if (kt + 2 < 16) { GB_XSTORE(0); }
    if (kt + 3 < 16) GB_XLOAD(kt + 3);
    __syncthreads();
  }
  if (nmt >= 0) {
    const char* AbaseN = (const char*)(A + (size_t)nmt * (NB * 32) * 1024);
    const u16* WfN = W + ((size_t)((nnt * 256 >> 5) + wave * 2) * 64 * 64 + lane) * 8;
#pragma unroll
    for (int rep = 0; rep < NB; ++rep) xr[rep] = *(const u32x4*)(AbaseN + (size_t)(rep * 65536) + xoff);
#pragma unroll
    for (int a = 0; a < 2; ++a)
#pragma unroll
      for (int ks = 0; ks < 4; ++ks) wq[a * 4 + ks] = *(const u32x4*)(WfN + (size_t)(a * 64 + ks) * 512);
  }
  const int nbw = n0 + wave * 64;
  const bool FUSE_POST = (MODE == 3) && (gridDim.x >= 512u);
  if (MODE == 0 && nbw >= NP) return;
#pragma unroll
  for (int b = 0; b < NB; ++b) {
    const int tok = m0 + b * 32 + r31;
    if (MODE == 0) {
      const float rs = p.rstd()[tok];
      const bool rope = (nbw < 512) || (nbw >= 1664 && nbw < 1984) || (nbw == 2048) || (nbw == 2176);
      u16* dst = p.proj() + (size_t)tok * NP + nbw;
      if (rope) {
#pragma unroll
        for (int gp = 0; gp < 2; ++gp) {
          float lo[8], hi[8];
#pragma unroll
          for (int u = 0; u < 2; ++u) {
            const int g = 2 * gp + u;
            const u32x4 csv = *(const u32x4*)((const unsigned*)p.c64() + tok * 32 + 8 * g + 4 * h);
            const float c_[4] = {bflo(csv.x), bflo(csv.y), bflo(csv.z), bflo(csv.w)};
            const float s_[4] = {bfhi(csv.x), bfhi(csv.y), bfhi(csv.z), bfhi(csv.w)};
#pragma unroll
            for (int r = 0; r < 4; ++r) {
              const float x1 = acc[0][b][4 * g + r] * rs, x2 = acc[1][b][4 * g + r] * rs;
              lo[4 * u + r] = x1 * c_[r] - x2 * s_[r];
              hi[4 * u + r] = x1 * s_[r] + x2 * c_[r];
            }
          }
          store8_pair(dst + 16 * gp, lo[0], lo[1], lo[2], lo[3], lo[4], lo[5], lo[6], lo[7], h);
          store8_pair(dst + 32 + 16 * gp, hi[0], hi[1], hi[2], hi[3], hi[4], hi[5], hi[6], hi[7], h);
        }
      } else {
#pragma unroll
        for (int a = 0; a < 2; ++a)
#pragma unroll
          for (int gp = 0; gp < 2; ++gp)
            store8_pair(dst + a * 32 + 16 * gp, acc[a][b][8 * gp] * rs, acc[a][b][8 * gp + 1] * rs, acc[a][b][8 * gp + 2] * rs, acc[a][b][8 * gp + 3] * rs,
                        acc[a][b][8 * gp + 4] * rs, acc[a][b][8 * gp + 5] * rs, acc[a][b][8 * gp + 6] * rs, acc[a][b][8 * gp + 7] * rs, h);
      }
    } else if (!FUSE_POST) {
      u16* y = p.proj() + (size_t)tok * 1024 + nbw;
#pragma unroll
      for (int a = 0; a < 2; ++a)
#pragma unroll
        for (int g = 0; g < 4; ++g)
          store4(y + a * 32 + 8 * g + 4 * h, acc[a][b][4 * g], acc[a][b][4 * g + 1], acc[a][b][4 * g + 2], acc[a][b][4 * g + 3]);
    }
  }
  if (MODE == 3 && FUSE_POST) {
    float* part_s = (float*)smem;
    float* tot_s = (float*)(smem + 2048);
    float* pg0 = p.xpart() + ((size_t)((l * 2 + 0) * 128 + mt) * 4) * 128;
    float* pg1 = p.xpart() + ((size_t)((l * 2 + 1) * 128 + mt) * 4) * 128;
    unsigned* c0 = p.xcnt() + (l * 2 + 0) * 128 + mt;
    unsigned* c1 = p.xcnt() + (l * 2 + 1) * 128 + mt;
#pragma unroll
    for (int b = 0; b < NB; ++b) {
      float ss = 0.f;
#pragma unroll
      for (int a = 0; a < 2; ++a)
#pragma unroll
        for (int i = 0; i < 16; ++i) ss += acc[a][b][i] * acc[a][b][i];
      ss += xor32(ss);
      if (h == 0) part_s[wave * 128 + b * 32 + r31] = ss;
    }
    row_exchange(part_s, tot_s, pg0, c0, nt, tid);
    const float* gp = p.g_post + l * 1024 + nbw;
    float ss2[4];
#pragma unroll
    for (int b = 0; b < NB; ++b) {
      const int tok = m0 + b * 32 + r31;
      const float rs = rsqrtf(tot_s[b * 32 + r31] * (1.0f / 1024.0f) + EPS);
      float s2 = 0.f;
#pragma unroll
      for (int a = 0; a < 2; ++a)
#pragma unroll
        for (int gq = 0; gq < 2; ++gq) {
          f32x4 ov[2];
          u32x2 xg[2];
          load8_pair(p.xb() + (size_t)tok * 1024 + nbw + a * 32 + 16 * gq, h, xg[0], xg[1]);
#pragma unroll
          for (int u = 0; u < 2; ++u) {
            const int g = 2 * gq + u;
            const int c = a * 32 + 8 * g + 4 * h;
            const f32x4 gv = *(const f32x4*)(gp + c);
            f32x4 xv;
            {
              const u32x2 xb2 = xg[u];
              xv.x = bflo(xb2.x); xv.y = bfhi(xb2.x); xv.z = bflo(xb2.y); xv.w = bfhi(xb2.y);
            }
            f32x4 o;
            o.x = xv.x + acc[a][b][4 * g] * rs * gv.x; o.y = xv.y + acc[a][b][4 * g + 1] * rs * gv.y;
            o.z = xv.z + acc[a][b][4 * g + 2] * rs * gv.z; o.w = xv.w + acc[a][b][4 * g + 3] * rs * gv.w;
            if (l == 1) *(f32x4*)(p.out + (size_t)tok * 1024 + nbw + c) = o;
            else s2 += o.x * o.x + o.y * o.y + o.z * o.z + o.w * o.w;
            ov[u] = o;
          }
          if (l == 0) store8_pair(p.xb() + (size_t)tok * 1024 + nbw + a * 32 + 16 * gq, ov[0].x, ov[0].y, ov[0].z, ov[0].w, ov[1].x, ov[1].y, ov[1].z, ov[1].w, h);
          __builtin_amdgcn_sched_barrier(0);
        }
      ss2[b] = s2;
    }
    if (l == 0) {
      __syncthreads();
#pragma unroll
      for (int b = 0; b < NB; ++b) {
        const float s2 = ss2[b] + xor32(ss2[b]);
        if (h == 0) part_s[wave * 128 + b * 32 + r31] = s2;
      }
      row_exchange(part_s, tot_s, pg1, c1, nt, tid);
      if (nt == 0 && tid < 128) p.rstd()[m0 + tid] = rsqrtf(tot_s[tid] * (1.0f / 1024.0f) + EPS);
    }
  }
}


DI void gemm_p14(const Params& p, int l, int mt, unsigned char* smem, int tid) {
  const int lane = tid & 63, wave = tid >> 6, r31 = lane & 31, h = lane >> 5;
  const int wt = wave >> 1, wc = wave & 1;
  const int m0 = mt * 64;
  const u16* A = p.xb();
  const u16* Wf = p.WinT() + (size_t)l * NPW * 1024 + ((size_t)(112 + wc) * 64 * 64 + lane) * 8;
  f32x16 acc;
#pragma unroll
  for (int i = 0; i < 16; ++i) acc[i] = 0.f;
  const int lrow = tid >> 3, lch = tid & 7;
  const char* Abase = (const char*)(A + (size_t)m0 * 1024);
  const unsigned xoff = (unsigned)((lrow * 1024 + lch * 8) * 2);
  u32x4 xr[2], wq[4];
#define P14_XLOAD(KTI) { _Pragma("unroll") for (int rep = 0; rep < 2; ++rep) xr[rep] = *(const u32x4*)(Abase + (size_t)(rep * 65536 + (KTI) * 128) + xoff); }
#define P14_XSTORE(BUF) { _Pragma("unroll") for (int rep = 0; rep < 2; ++rep) *(u32x4*)((u16*)(smem + (BUF) * 18432) + (lrow + rep * 32) * 72 + lch * 8) = xr[rep]; }
#define P14_WLD(KS_, KTI) (*(const u32x4*)(Wf + (size_t)((KTI) * 4 + (KS_)) * 512))
#define P14_COMPUTE(BUF, KTI) { const u16* Xb = (const u16*)(smem + (BUF) * 18432); \
    _Pragma("unroll") for (int ks = 0; ks < 4; ++ks) { \
      const bf16x8 xf = *(const bf16x8*)(Xb + (wt * 32 + r31) * 72 + ks * 16 + h * 8); \
      acc = MFMA32(__builtin_bit_cast(bf16x8, wq[ks]), xf, acc); \
      if ((KTI) + 1 < 16) wq[ks] = P14_WLD(ks, (KTI) + 1); \
      __builtin_amdgcn_sched_barrier(0); } }
  __syncthreads();
  P14_XLOAD(0);
#pragma unroll
  for (int ks = 0; ks < 4; ++ks) wq[ks] = P14_WLD(ks, 0);
  P14_XSTORE(0);
  P14_XLOAD(1);
  __syncthreads();
  for (int kt = 0; kt < 16; kt += 2) {
    P14_COMPUTE(0, kt);
    P14_XSTORE(1);
    if (kt + 2 < 16) P14_XLOAD(kt + 2);
    __syncthreads();
    P14_COMPUTE(1, kt + 1);
    if (kt + 2 < 16) { P14_XSTORE(0); }
    if (kt + 3 < 16) P14_XLOAD(kt + 3);
    __syncthreads();
  }
  const int tok = m0 + wt * 32 + r31;
  const float rs = p.rstd()[tok];
  u16* dst = p.proj() + (size_t)tok * NP + C_KR + wc * 32;
#pragma unroll
  for (int gp = 0; gp < 2; ++gp)
    store8_pair(dst + 16 * gp, acc[8 * gp] * rs, acc[8 * gp + 1] * rs, acc[8 * gp + 2] * rs, acc[8 * gp + 3] * rs,
                acc[8 * gp + 4] * rs, acc[8 * gp + 5] * rs, acc[8 * gp + 6] * rs, acc[8 * gp + 7] * rs, h);
}

DI void compress_job(const Params& p, int l, int kv, int rt, unsigned char* smem, int tid) {
  const int lane = tid & 63, wave = tid >> 6, r31 = lane & 31, h = lane >> 5;
  u16* Hs = (u16*)(smem + 41472);
  const u16* W1 = p.W1T() + (size_t)(l * 2 + kv) * 256 * 2048;
  const u16* W2 = p.W2T() + (size_t)(l * 2 + kv) * 64 * 256;
  const float* pos = (kv ? p.pos_v : p.pos_k) + l * 2048;
  const int segc = kv ? CC_VC : CC_KC;

  const int lrow = tid >> 3, lch = tid & 7;
  int r = rt * 32 + lrow; if (r > 1015) r = 1015;
  const int ab = r / 127, an = r % 127;
  const u16* arow = p.proj() + (size_t)(ab * 2048 + 16 * an) * NP + segc + lch * 8;

  f32x16 acc[2];
#pragma unroll
  for (int a = 0; a < 2; ++a)
#pragma unroll
    for (int i = 0; i < 16; ++i) acc[a][i] = 0.f;

  const u16* Wf = W1 + ((size_t)(wave * 2) * 128 * 64 + lane) * 8;
  u32x4 xr, wq[8];
#define C_XLOAD(KTI) { \
    const u32x4 v_ = *(const u32x4*)(arow + (size_t)(KTI) * NP); \
    const f32x4 p0_ = *(const f32x4*)(pos + (KTI) * 64 + lch * 8); \
    const f32x4 p1_ = *(const f32x4*)(pos + (KTI) * 64 + lch * 8 + 4); \
    xr.x = pk2(bflo(v_.x) + p0_.x, bfhi(v_.x) + p0_.y); xr.y = pk2(bflo(v_.y) + p0_.z, bfhi(v_.y) + p0_.w); \
    xr.z = pk2(bflo(v_.z) + p1_.x, bfhi(v_.z) + p1_.y); xr.w = pk2(bflo(v_.w) + p1_.z, bfhi(v_.w) + p1_.w); }
#define C_XSTORE(BUF) { *(u32x4*)((u16*)(smem + (BUF) * 4608) + lrow * 72 + lch * 8) = xr; }
#define C_WLD(A_, KS_, KTI) (*(const u32x4*)(Wf + (size_t)((A_) * 128 + (KTI) * 4 + (KS_)) * 512))
#define C_COMPUTE(BUF, KTI) { const u16* Xb = (const u16*)(smem + (BUF) * 4608); \
    _Pragma("unroll") for (int ks = 0; ks < 4; ++ks) { \
      const bf16x8 xf = *(const bf16x8*)(Xb + r31 * 72 + ks * 16 + h * 8); \
      _Pragma("unroll") for (int a = 0; a < 2; ++a) { \
        acc[a] = MFMA32(__builtin_bit_cast(bf16x8, wq[a * 4 + ks]), xf, acc[a]); \
        if ((KTI) + 1 < 32) wq[a * 4 + ks] = C_WLD(a, ks, (KTI) + 1); } } }
  __syncthreads();
  C_XLOAD(0);
#pragma unroll
  for (int a = 0; a < 2; ++a)
#pragma unroll
    for (int ks = 0; ks < 4; ++ks) wq[a * 4 + ks] = C_WLD(a, ks, 0);
  C_XSTORE(0);
  C_XLOAD(1);
  __syncthreads();
  for (int kt = 0; kt < 32; kt += 2) {
    C_COMPUTE(0, kt);
    C_XSTORE(1);
    if (kt + 2 < 32) C_XLOAD(kt + 2);
    __syncthreads();
    C_COMPUTE(1, kt + 1);
    if (kt + 2 < 32) { C_XSTORE(0); }
    if (kt + 3 < 32) C_XLOAD(kt + 3);
    __syncthreads();
  }
#pragma unroll
  for (int a = 0; a < 2; ++a)
#pragma unroll
    for (int g = 0; g < 4; ++g)
      store4(Hs + r31 * 264 + wave * 64 + a * 32 + 8 * g + 4 * h, siluf_(acc[a][4 * g]), siluf_(acc[a][4 * g + 1]), siluf_(acc[a][4 * g + 2]), siluf_(acc[a][4 * g + 3]));
  __syncthreads();
  if (wave < 2) {
    f32x16 o;
#pragma unroll
    for (int i = 0; i < 16; ++i) o[i] = 0.f;
#pragma unroll 4
    for (int ks = 0; ks < 16; ++ks) {
      const bf16x8 wf = *(const bf16x8*)(W2 + (size_t)(wave * 32 + r31) * 256 + ks * 16 + h * 8);
      const bf16x8 hf = *(const bf16x8*)(Hs + r31 * 264 + ks * 16 + h * 8);
      o = MFMA32(wf, hf, o);
    }
    const int rr = rt * 32 + r31;
    if (rr < 1016) {
      const int b = rr / 127, n = rr % 127;
      u16* dst = (kv ? p.vc() : p.kc()) + (size_t)(b * 128 + n) * 64 + wave * 32;
#pragma unroll
      for (int g = 0; g < 4; ++g) store4(dst + 8 * g + 4 * h, o[4 * g], o[4 * g + 1], o[4 * g + 2], o[4 * g + 3]);
    }
  }
}

enum { M_A = 0, M_B = 1, M_WIN = 2, M_SLC = 3, M_D = 4 };
constexpr float LOG2E = 1.4426950408889634f;
constexpr int L_TAB = 59392;
constexpr int L_DFLAG = 70800;

DI float ex2(float x) { return __builtin_amdgcn_exp2f(x); }
DI float lg2(float x) { return __builtin_amdgcn_logf(x); }

DI int next_slc(unsigned tm, int kt) { const unsigned mk = tm & ((1u << kt) - 1u); return mk ? 31 - __builtin_clz(mk) : -1; }

DI float dil_log2w(int dist) {
  const int c1 = (dist <= 128) ? 1 : 0;
  const int c2 = (((dist & 3) == 0) && dist <= 512) ? 1 : 0;
  const int c3 = ((dist & 15) == 0) ? 1 : 0;
  const int w = c1 + c2 + c3;
  const float lw = (w == 3) ? 1.5849625007211562f : ((w == 2) ? 1.0f : 0.f);
  return (dist >= 0 && w > 0) ? lw : NEGM;
}

template <int MODE, bool MASKED>
DI void softmax_tile(f32x16 (&s)[2], int d0, float sc2, bool selbit, const float* tb, float& m, float& lsum, f32x16& o0, f32x16& o1) {
  if (!MASKED && MODE != M_A) {
    const bool live = (MODE != M_SLC) || selbit;
    float mr = NEGM;
#pragma unroll
    for (int ks = 0; ks < 2; ++ks)
#pragma unroll
      for (int i = 0; i < 16; ++i) mr = fmaxf(mr, s[ks][i]);
    mr = fmaxf(mr, xor32(mr));
    const float mx = live ? fmaxf(m, mr * sc2) : m;
    const float alpha = ex2(m - mx);
    m = mx;
    const float nmx = live ? -mx : NEGM;
    float psum = 0.f;
#pragma unroll
    for (int ks = 0; ks < 2; ++ks)
#pragma unroll
      for (int i = 0; i < 16; ++i) {
        const float pe = ex2(fmaf(s[ks][i], sc2, nmx));
        s[ks][i] = pe;
        psum += pe;
      }
    lsum = lsum * alpha + psum;
#pragma unroll
    for (int i = 0; i < 16; ++i) { o0[i] *= alpha; o1[i] *= alpha; }
    return;
  }
  float mx = m;
  const float lb = (MODE == M_SLC && !selbit) ? NEGM : 0.f;
#pragma unroll
  for (int ks = 0; ks < 2; ++ks)
#pragma unroll
    for (int i = 0; i < 16; ++i) {
      const int c = ks * 32 + 8 * (i >> 2) + (i & 3);
      float sv;
      if (MODE == M_A) sv = s[ks][i] * sc2 + tb[63 - c];
      else if (!MASKED) sv = (MODE == M_SLC) ? (s[ks][i] * sc2 + lb) : (s[ks][i] * sc2);
      else {
        const int dist = d0 - c;
        bool ok;
        if (MODE == M_WIN) ok = ((unsigned)dist <= 511u);
        else if (MODE == M_SLC) ok = selbit && (dist >= 0);
        else ok = (dist >= 0);
        sv = ok ? (s[ks][i] * sc2) : NEGM;
      }
      s[ks][i] = sv;
      mx = fmaxf(mx, sv);
    }
  mx = fmaxf(mx, xor32(mx));
  const float alpha = ex2(m - mx);
  m = mx;
  float psum = 0.f;
#pragma unroll
  for (int ks = 0; ks < 2; ++ks)
#pragma unroll
    for (int i = 0; i < 16; ++i) {
      const float pe = ex2(s[ks][i] - mx);
      s[ks][i] = pe;
      psum += pe;
    }
  lsum = lsum * alpha + psum;
#pragma unroll
  for (int i = 0; i < 16; ++i) { o0[i] *= alpha; o1[i] *= alpha; }
}

template <bool MASKED>
DI void stick_tile(f32x16 (&s)[2], int d0, float sc2, int h, float& R) {
  f32x16 lk[2];
  float G[2][4], Gp[2][4];
#pragma unroll
  for (int ks = 0; ks < 2; ++ks)
#pragma unroll
    for (int i = 0; i < 16; ++i) {
      const float z = s[ks][i] * sc2;
      const float e = ex2(-fabsf(z));
      const float lp = lg2(1.0f + e);
      float v = fminf(-z, 0.f) - lp;
      if (MASKED) { const int dist = d0 - (ks * 32 + 8 * (i >> 2) + (i & 3)); v = (dist > 0) ? v : 0.f; }
      s[ks][i] = z;
      lk[ks][i] = v;
    }
#pragma unroll
  for (int ks = 0; ks < 2; ++ks)
#pragma unroll
    for (int g = 0; g < 4; ++g) {
      G[ks][g] = (lk[ks][4 * g] + lk[ks][4 * g + 1]) + (lk[ks][4 * g + 2] + lk[ks][4 * g + 3]);
      Gp[ks][g] = xor32(G[ks][g]);
    }
  float accs = 0.f;
#pragma unroll
  for (int ks = 1; ks >= 0; --ks)
#pragma unroll
    for (int g = 3; g >= 0; --g) {
      const float base = R + accs + (h == 0 ? Gp[ks][g] : 0.f);
      float run = 0.f;
#pragma unroll
      for (int r = 3; r >= 0; --r) {
        const int i = 4 * g + r;
        float a = ex2(s[ks][i] + lk[ks][i] + (base + run));
        if (MASKED) { const int dist = d0 - (ks * 32 + 8 * g + r); a = (dist > 0) ? a : 0.f; }
        run += lk[ks][i];
        s[ks][i] = a;
      }
      accs += G[ks][g] + Gp[ks][g];
    }
  R += accs;
}

#define ATT_ISSUE(KT) { \
    _Pragma("unroll") for (int rep = 0; rep < NKR; ++rep) { const int c = tid + rep * 256; const int key = c / (KC * 2), ch = c % (KC * 2); \
      kr[rep] = *(const u32x4*)(Kg + (size_t)((KT) * 64 + key) * ldk + ch * 8); } \
    vr0 = *(const u32x4*)(Vg + (size_t)((KT) * 64 + 2 * vkp) * ldv + vdc * 8); \
    vr1 = *(const u32x4*)(Vg + (size_t)((KT) * 64 + 2 * vkp + 1) * ldv + vdc * 8); }
#define ATT_COMMIT(BUF) { u16* Ksw = (u16*)(smem + (BUF) * 36864); unsigned* vd = (unsigned*)(smem + (BUF) * 36864 + 13312) + (vdc * 8) * 34 + vkp; \
    _Pragma("unroll") for (int rep = 0; rep < NKR; ++rep) { const int c = tid + rep * 256; const int key = c / (KC * 2), ch = c % (KC * 2); \
      *(u32x4*)(Ksw + key * KST + ch * 8) = kr[rep]; } \
    vd[0 * 34] = (vr0.x & 0xffffu) | (vr1.x << 16); vd[1 * 34] = (vr0.x >> 16) | (vr1.x & 0xffff0000u); \
    vd[2 * 34] = (vr0.y & 0xffffu) | (vr1.y << 16); vd[3 * 34] = (vr0.y >> 16) | (vr1.y & 0xffff0000u); \
    vd[4 * 34] = (vr0.z & 0xffffu) | (vr1.z << 16); vd[5 * 34] = (vr0.z >> 16) | (vr1.z & 0xffff0000u); \
    vd[6 * 34] = (vr0.w & 0xffffu) | (vr1.w << 16); vd[7 * 34] = (vr0.w >> 16) | (vr1.w & 0xffff0000u); }
#define ATT_NEXT(KT) ((MODE == M_SLC) ? next_slc(tm, (KT)) : ((((KT) - 1) >= kt_lo) ? ((KT) - 1) : -1))

template <int MODE, int KC>
DI void attn_loop(const u16* __restrict__ Kg, int ldk, const u16* __restrict__ Vg, int ldv, int kt_hi, int kt_lo,
                  unsigned tilemask, const bf16x8 (&qf)[KC], int qpos, float scale, unsigned selbits, float& m,
                  float& lsum, float& R, f32x16& o0, f32x16& o1, unsigned char* smem, int tid) {
  constexpr int KST = KC * 16 + 8;
  constexpr int NKR = KC / 2;
  const int lane = tid & 63, r31 = lane & 31, h = lane >> 5, wave = tid >> 6;
  const float sc2 = scale * LOG2E;
  const int q0 = __builtin_amdgcn_readfirstlane(qpos);
  unsigned tm = tilemask;
  if (MODE == M_SLC) { if (kt_hi < 31) tm &= ((2u << kt_hi) - 1u); }
  int kt = (MODE == M_SLC) ? (tm ? 31 - __builtin_clz(tm) : -1) : kt_hi;
  if (kt < kt_lo) return;
  const int vkp = tid & 31, vdc = tid >> 5;
  const float* tab = (const float*)(smem + L_TAB);
  volatile int* dflag = (volatile int*)(smem + L_DFLAG);
  u32x4 kr[NKR], vr0, vr1;
  ATT_ISSUE(kt);
  __syncthreads();
  ATT_COMMIT(0);
  int nxt = ATT_NEXT(kt);
  if (nxt >= 0) ATT_ISSUE(nxt);
  __syncthreads();
  int buf = 0, it = 0;
  for (;;) {
    const u16* Ks = (const u16*)(smem + buf * 36864);
    const u16* Vt = (const u16*)(smem + buf * 36864 + 13312);
    const int k0 = kt * 64;
    int cls;
    if (MODE == M_A) cls = 2;
    else if (MODE == M_B || MODE == M_SLC) cls = (k0 > q0 + 31) ? 0 : ((k0 + 63 <= q0) ? 1 : 2);
    else if (MODE == M_D) cls = (k0 >= q0 + 31) ? 0 : ((k0 + 63 < q0) ? 1 : 2);
    else cls = (k0 > q0 + 31 || q0 - (k0 + 63) > 511) ? 0 : ((k0 + 63 <= q0 && q0 + 31 - k0 <= 511) ? 1 : 2);
    if (cls != 0) {
      f32x16 s[2];
#pragma unroll
      for (int i = 0; i < 16; ++i) { s[0][i] = 0.f; s[1][i] = 0.f; }
#pragma unroll
      for (int kc = 0; kc < KC; ++kc) {
        const bf16x8 a0 = *(const bf16x8*)(Ks + r31 * KST + kc * 16 + h * 8);
        const bf16x8 a1 = *(const bf16x8*)(Ks + (32 + r31) * KST + kc * 16 + h * 8);
        s[0] = MFMA32(a0, qf[kc], s[0]);
        s[1] = MFMA32(a1, qf[kc], s[1]);
      }
      const int d0 = qpos - k0 - 4 * h;
      if (MODE == M_D) {
        if (cls == 1) stick_tile<false>(s, d0, sc2, h, R);
        else stick_tile<true>(s, d0, sc2, h, R);
      } else {
        const bool selbit = (selbits >> kt) & 1u;
        const float* tb = tab + (d0 + 65);
        if (cls == 1) softmax_tile<MODE, false>(s, d0, sc2, selbit, tb, m, lsum, o0, o1);
        else softmax_tile<MODE, true>(s, d0, sc2, selbit, tb, m, lsum, o0, o1);
      }
#pragma unroll
      for (int ks = 0; ks < 2; ++ks)
#pragma unroll
        for (int s2 = 0; s2 < 2; ++s2) {
          const bf16x8 pb = pack8(s[ks][8 * s2 + 0], s[ks][8 * s2 + 1], s[ks][8 * s2 + 2], s[ks][8 * s2 + 3], s[ks][8 * s2 + 4], s[ks][8 * s2 + 5], s[ks][8 * s2 + 6], s[ks][8 * s2 + 7]);
          const int koff = ks * 32 + 16 * s2 + 4 * h;
          const bf16x8 va = ld2x8(Vt + r31 * 68 + koff, Vt + r31 * 68 + koff + 8);
          const bf16x8 vb = ld2x8(Vt + (32 + r31) * 68 + koff, Vt + (32 + r31) * 68 + koff + 8);
          o0 = MFMA32(va, pb, o0);
          o1 = MFMA32(vb, pb, o1);
        }
    }
    if (nxt < 0) break;
    if (MODE == M_D) {
      const bool done = (__ballot(R < -200.0f) == ~0ull);
      if (lane == 0) dflag[(it & 1) * 4 + wave] = done ? 1 : 0;
    }
    ATT_COMMIT(buf ^ 1);
    kt = nxt;
    nxt = ATT_NEXT(kt);
    if (nxt >= 0) ATT_ISSUE(nxt);
    __syncthreads();
    if (MODE == M_D) {
      const int a = (it & 1) * 4;
      if (dflag[a] & dflag[a + 1] & dflag[a + 2] & dflag[a + 3]) break;
    }
    buf ^= 1;
    ++it;
  }
}

DI void store_gated(const f32x16& o0, const f32x16& o1, const u16* __restrict__ gate, u16* __restrict__ dst, int h) {
#pragma unroll
  for (int ds = 0; ds < 2; ++ds)
#pragma unroll
    for (int gq = 0; gq < 2; ++gq) {
      const f32x16& o = ds ? o1 : o0;
      float v[8];
#pragma unroll
      for (int u = 0; u < 2; ++u) {
        const int g = 2 * gq + u;
        const u32x2 gv = *(const u32x2*)(gate + ds * 32 + 8 * g + 4 * h);
        v[4 * u + 0] = o[4 * g] * siluf_(bflo(gv.x)); v[4 * u + 1] = o[4 * g + 1] * siluf_(bfhi(gv.x));
        v[4 * u + 2] = o[4 * g + 2] * siluf_(bflo(gv.y)); v[4 * u + 3] = o[4 * g + 3] * siluf_(bfhi(gv.y));
      }
      store8_pair(dst + ds * 32 + 16 * gq, v[0], v[1], v[2], v[3], v[4], v[5], v[6], v[7], h);
    }
}

DI void zero16(f32x16& v) {
#pragma unroll
  for (int i = 0; i < 16; ++i) v[i] = 0.f;
}

template <int MODE>
DI void attn_job_abd(const Params& p, int b, int hd, int qb, unsigned char* smem, int tid) {
  constexpr int KC = (MODE == M_B) ? 6 : 4;
  const int lane = tid & 63, wave = tid >> 6, r31 = lane & 31, h = lane >> 5;
  const int qpos = qb * 128 + wave * 32 + r31;
  const size_t tok = (size_t)b * SEQ + qpos;
  const size_t tb0 = (size_t)b * SEQ;
  const u16 *Qp, *Kg, *Vg, *gate; int ldk, ldv, ocol; float scale;
  if (MODE == M_A) {
    Qp = p.proj() + tok * NP + CA_Q + hd * 64; Kg = p.proj() + tb0 * NP + CA_K + hd * 64; Vg = p.proj() + tb0 * NP + CA_V + hd * 64;
    ldk = NP; ldv = NP; gate = p.proj() + tok * NP + CA_G + hd * 64; ocol = 0; scale = 0.125f;
  } else if (MODE == M_B) {
    Qp = p.qB() + tok * 384 + hd * 96; Kg = p.kB() + tb0 * 384 + hd * 96; Vg = p.vB() + tb0 * 256 + hd * 64;
    ldk = 384; ldv = 256; gate = p.proj() + tok * NP + CB_G + hd * 64; ocol = 256; scale = 0.10206207261596577f;
  } else {
    Qp = p.proj() + tok * NP + CD_Q + hd * 64; Kg = p.proj() + tb0 * NP + CD_K + hd * 64; Vg = p.proj() + tb0 * NP + CD_V + hd * 64;
    ldk = NP; ldv = NP; gate = p.proj() + tok * NP + CD_G + hd * 64; ocol = 768; scale = 0.125f;
  }
  bf16x8 qf[KC];
#pragma unroll
  for (int kc = 0; kc < KC; ++kc) qf[kc] = *(const bf16x8*)(Qp + kc * 16 + h * 8);
  f32x16 o0, o1; zero16(o0); zero16(o1);
  float m = MINIT, lsum = 0.f, R = 0.f;
  if (MODE == M_A) {
    __syncthreads();
    float* tab = (float*)(smem + L_TAB);
    for (int i = tid; i < 2176; i += 256) tab[i] = dil_log2w(i - 128);
  }
  attn_loop<MODE, KC>(Kg, ldk, Vg, ldv, 2 * qb + 1, 0, 0xffffffffu, qf, qpos, scale, 0u, m, lsum, R, o0, o1, smem, tid);
  if (MODE != M_D) {
    const float lt = lsum + xor32(lsum);
    const float inv = 1.0f / lt;
#pragma unroll
    for (int i = 0; i < 16; ++i) { o0[i] *= inv; o1[i] *= inv; }
  }
  store_gated(o0, o1, gate, p.mixed() + tok * 1024 + ocol + hd * 64, h);
}

DI void attn_job_c(const Params& p, int b, int tb, unsigned char* smem, int tid) {
  const int lane = tid & 63, wave = tid >> 6, r31 = lane & 31, h = lane >> 5;
  const int t0 = tb * 32;
  const int qpos = t0 + r31;
  const size_t tok = (size_t)b * SEQ + qpos;
  const size_t tb0 = (size_t)b * SEQ;
  const u16* prow = p.proj() + tok * NP;
  bf16x8 qf[4];
#pragma unroll
  for (int kc = 0; kc < 4; ++kc) qf[kc] = *(const bf16x8*)(prow + CC_Q + wave * 64 + kc * 16 + h * 8);
  const float g0 = sigmoidf_(bf2f(prow[C_GL + wave * 3 + 0]));
  const float g1 = sigmoidf_(bf2f(prow[C_GL + wave * 3 + 1]));
  const float g2 = sigmoidf_(bf2f(prow[C_GL + wave * 3 + 2]));
  f32x16 acc0, acc1;

  u16* Kc = (u16*)smem;
  u16* Vct = (u16*)(smem + 18432);
  float* impw = (float*)(smem + L_IMPW);
  float* p3w = (float*)(smem + L_P3W);
  float* impf = (float*)smem;
  unsigned* selm = (unsigned*)(smem + L_SELM);
  unsigned* selany = (unsigned*)(smem + L_SELANY);

  __syncthreads();
  {
    const u16* kcg = p.kc() + (size_t)b * 128 * 64;
    const u16* vcg = p.vc() + (size_t)b * 128 * 64;
#pragma unroll
    for (int rep = 0; rep < 4; ++rep) {
      const int c = tid + rep * 256;
      const int key = c >> 3, ch = c & 7;
      *(u32x4*)(Kc + key * 72 + ch * 8) = *(const u32x4*)(kcg + key * 64 + ch * 8);
    }
#pragma unroll
    for (int rep = 0; rep < 4; ++rep) {
      const int c = tid + rep * 256;
      const int key = c & 127, dc = c >> 7;
      const u32x4 v = *(const u32x4*)(vcg + key * 64 + dc * 8);
      u16* d = Vct + (dc * 8) * 132 + key;
      d[0 * 132] = (u16)(v.x & 0xffffu); d[1 * 132] = (u16)(v.x >> 16);
      d[2 * 132] = (u16)(v.y & 0xffffu); d[3 * 132] = (u16)(v.y >> 16);
      d[4 * 132] = (u16)(v.z & 0xffffu); d[5 * 132] = (u16)(v.z >> 16);
      d[6 * 132] = (u16)(v.w & 0xffffu); d[7 * 132] = (u16)(v.w >> 16);
    }
    if (tid < 32) selm[tid] = 0u;
    if (tid == 32) *selany = 0u;
  }
  __syncthreads();
  {
    f32x16 s[4];
#pragma unroll
    for (int q = 0; q < 4; ++q) zero16(s[q]);
#pragma unroll
    for (int q = 0; q < 4; ++q)
#pragma unroll
      for (int kc = 0; kc < 4; ++kc) {
        const bf16x8 a = *(const bf16x8*)(Kc + (q * 32 + r31) * 72 + kc * 16 + h * 8);
        s[q] = MFMA32(a, qf[kc], s[q]);
      }
    float mx = NEGM;
#pragma unroll
    for (int q = 0; q < 4; ++q)
#pragma unroll
      for (int i = 0; i < 16; ++i) {
        const int n = q * 32 + 8 * (i >> 2) + 4 * h + (i & 3);
        const bool ok = (16 * n + 31 <= qpos);
        const float sv = ok ? s[q][i] * 0.125f : NEGM;
        s[q][i] = sv;
        mx = fmaxf(mx, sv);
      }
    mx = fmaxf(mx, xor32(mx));
    float den = 0.f;
#pragma unroll
    for (int q = 0; q < 4; ++q)
#pragma unroll
      for (int i = 0; i < 16; ++i) {
        const float e = (s[q][i] == NEGM) ? 0.f : __expf(s[q][i] - mx);
        s[q][i] = e;
        den += e;
      }
    den += xor32(den);
    const float inv = 1.0f / fmaxf(den, 1e-30f);
#pragma unroll
    for (int q = 0; q < 4; ++q)
#pragma unroll
      for (int i = 0; i < 16; ++i) s[q][i] *= inv;
#pragma unroll
    for (int q = 0; q < 4; ++q)
#pragma unroll
      for (int g = 0; g < 4; ++g) {
        const int j0 = 8 * q + 2 * g + h;
        impw[(wave * 32 + r31) * 33 + j0] = (s[q][4 * g] + s[q][4 * g + 1]) + (s[q][4 * g + 2] + s[q][4 * g + 3]);
        p3w[(wave * 32 + r31) * 33 + j0] = s[q][4 * g + 3];
      }
    f32x16 o0, o1; zero16(o0); zero16(o1);
#pragma unroll
    for (int q = 0; q < 4; ++q)
#pragma unroll
      for (int s2 = 0; s2 < 2; ++s2) {
        const bf16x8 pb = pack8(s[q][8 * s2 + 0], s[q][8 * s2 + 1], s[q][8 * s2 + 2], s[q][8 * s2 + 3], s[q][8 * s2 + 4], s[q][8 * s2 + 5], s[q][8 * s2 + 6], s[q][8 * s2 + 7]);
        const int koff = q * 32 + 16 * s2 + 4 * h;
        const bf16x8 va = ld2x8(Vct + r31 * 132 + koff, Vct + r31 * 132 + koff + 8);
        const bf16x8 vb = ld2x8(Vct + (32 + r31) * 132 + koff, Vct + (32 + r31) * 132 + koff + 8);
        o0 = MFMA32(va, pb, o0);
        o1 = MFMA32(vb, pb, o1);
        __builtin_amdgcn_sched_barrier(0);
      }
#pragma unroll
    for (int i = 0; i < 16; ++i) { acc0[i] = g0 * o0[i]; acc1[i] = g0 * o1[i]; }
  }
  __syncthreads();
  {
    const int tl = tid >> 3, jb = (tid & 7) * 4;
    const int bt = (t0 + tl) >> 6;
#pragma unroll
    for (int c = 0; c < 4; ++c) {
      const int j = jb + c;
      float v = 0.f;
#pragma unroll
      for (int w = 0; w < 4; ++w) {
        v += impw[(w * 32 + tl) * 33 + j];
        if (j > 0) v += p3w[(w * 32 + tl) * 33 + j - 1];
      }
      const bool forced = (j == 0) || (j == bt) || (j == bt - 1);
      v = forced ? 1e9f : ((j > bt) ? -1e9f : v);
      impf[tl * 33 + j] = v;
    }
  }
  __syncthreads();
  {
    const int tl = tid >> 3, jb = (tid & 7) * 4;
    const int bt = (t0 + tl) >> 6;
    unsigned bits = 0u;
#pragma unroll
    for (int c = 0; c < 4; ++c) {
      const int j = jb + c;
      const float v = impf[tl * 33 + j];
      int rank = 0;
      for (int jj = 0; jj < 32; ++jj) {
        const float vv = impf[tl * 33 + jj];
        rank += ((vv > v) || (vv == v && jj < j)) ? 1 : 0;
      }
      if (rank < 16 && j <= bt) bits |= (1u << j);
    }
    atomicOr(&selm[tl], bits);
    atomicOr(selany, bits);
  }
  __syncthreads();
  const unsigned mysel = selm[r31];
  const unsigned anysel = *selany;
  const int bt0 = t0 >> 6;
  {
    f32x16 o0, o1; zero16(o0); zero16(o1);
    float m = MINIT, lsum = 0.f, R = 0.f;
    attn_loop<M_SLC, 4>(p.proj() + tb0 * NP + CC_KS, NP, p.proj() + tb0 * NP + CC_VS, NP, bt0, 0, anysel, qf, qpos, 0.125f, mysel, m, lsum, R, o0, o1, smem, tid);
    const float lt = lsum + xor32(lsum);
    const float sc = g1 / lt;
#pragma unroll
    for (int i = 0; i < 16; ++i) { acc0[i] += sc * o0[i]; acc1[i] += sc * o1[i]; }
  }
  {
    f32x16 o0, o1; zero16(o0); zero16(o1);
    float m = MINIT, lsum = 0.f, R = 0.f;
    int lo = (t0 - 511) >> 6; if (lo < 0) lo = 0;
    attn_loop<M_WIN, 4>(p.proj() + tb0 * NP + CC_KW, NP, p.proj() + tb0 * NP + CC_VW, NP, bt0, lo, 0xffffffffu, qf, qpos, 0.125f, 0u, m, lsum, R, o0, o1, smem, tid);
    const float lt = lsum + xor32(lsum);
    const float sc = g2 / lt;
#pragma unroll
    for (int i = 0; i < 16; ++i) { acc0[i] += sc * o0[i]; acc1[i] += sc * o1[i]; }
  }
  store_gated(acc0, acc1, prow + CC_G + wave * 64, p.mixed() + tok * 1024 + 512 + wave * 64, h);
}

DI void phase_inproj(const Params& p, int l, int bid, int nb, unsigned char* smem, int tid) {
  {
    u32x4 xr[4], wq[8];
    bool pre = false;
    for (int tile = bid; tile < 1536; tile += nb) {
      int nmt = -1, nnt = 0;
      const int nx = tile + nb;
      if (nx < 1536) { nmt = nx % 128; nnt = nx / 128; }
      else if (nb == 512 && bid < 256) { nmt = bid % 128; nnt = 12 + bid / 128; }
      gemm_big<0, 4>(p, l, tile % 128, tile / 128, smem, launder(tid), xr, wq, pre, nmt, nnt);
      pre = (nmt >= 0);
    }
    for (int u = bid; u < 256; u += nb) { gemm_big<0, 4>(p, l, u % 128, 12 + u / 128, smem, launder(tid), xr, wq, pre && (nb == 512), -1, 0); pre = false; }
  }
  for (int u = (bid < 256 ? bid + ((256 - bid + nb - 1) / nb) * nb : bid); u < 512; u += nb) gemm_p14(p, l, u - 256, smem, launder(tid));
}

DI void prep_job(const Params& p, int l, int job, unsigned char* smem, int tid) {
  if (job < 64) compress_job(p, l, job >> 5, job & 31, smem, tid);
  else if (job < 448) { const int j = job - 64; gemm128<1>(p, l, j % 128, j / 128, smem, tid); }
  else if (job < 960) { const int j = job - 448; gemm128<2>(p, l, j % 128, j / 128, smem, tid); }
  else {
    const int j = job - 960;
    for (int it = tid; it < 1024; it += 256) {
      const int idx = j * 1024 + it;
      const int tok = idx >> 2, i4 = (idx & 3) * 4;
      const u32x2 a1 = *(const u32x2*)(p.proj() + (size_t)tok * NP + C_KR + i4);
      const u32x2 a2 = *(const u32x2*)(p.proj() + (size_t)tok * NP + C_KR + 16 + i4);
      const f32x4 cs = *(const f32x4*)(p.c32() + tok * 16 + i4);
      const f32x4 sn = *(const f32x4*)(p.s32() + tok * 16 + i4);
      const float x10 = bflo(a1.x), x11 = bfhi(a1.x), x12 = bflo(a1.y), x13 = bfhi(a1.y);
      const float x20 = bflo(a2.x), x21 = bfhi(a2.x), x22 = bflo(a2.y), x23 = bfhi(a2.y);
#pragma unroll
      for (int hd = 0; hd < 4; ++hd) {
        u16* kb = p.kB() + (size_t)tok * 384 + hd * 96 + 64 + i4;
        store4(kb, x10 * cs.x - x20 * sn.x, x11 * cs.y - x21 * sn.y, x12 * cs.z - x22 * sn.z, x13 * cs.w - x23 * sn.w);
        store4(kb + 16, x10 * sn.x + x20 * cs.x, x11 * sn.y + x21 * cs.y, x12 * sn.z + x22 * cs.z, x13 * sn.w + x23 * cs.w);
      }
    }
  }
}

DI void phase_attn(const Params& p, int lc, unsigned char* smem, int tid_in, const XcdBarrier& xb) {
  const int l = lc & 1;
  int* jobp = (int*)(smem + L_JOB);
  unsigned* xsub = (unsigned*)(p.ctr() + 16 + lc * 16);
  unsigned* ready = (unsigned*)(p.ctr() + 48 + lc);
  const int NCONV = (lc == 0) ? 128 : 0;
  bool left_prep = false, prep_ok = false;
  for (;;) {
    int tid = tid_in;
    asm volatile("" : "+v"(tid));
    __syncthreads();
    if (tid == 0) *jobp = atomicAdd(p.ctr() + lc, 1);
    __syncthreads();
    const int job = *jobp;
    if (job >= 1024 && !left_prep) {
      asm volatile("s_waitcnt vmcnt(0)" ::: "memory");
      __syncthreads();
      if (tid == 0) {
        const unsigned nloc = xb.st[0];
        const unsigned old = xb_add(&xsub[xb.st[2]], 1u);
        if (old + 1u == nloc) {
          __builtin_amdgcn_fence(__ATOMIC_RELEASE, "agent");
          asm volatile("s_waitcnt vmcnt(0)" ::: "memory");
          (void)xb_add(ready, 1u);
        }
      }
      left_prep = true;
    }
    if (job >= 3072 + NCONV) break;
    if (job < 1024) {
      prep_job(p, l, job, smem, tid);
    } else if (job < 1024 + NCONV) {
      conv_weights(p, 1, (job - 1024) * 256 + tid, NCONV * 256);
    } else if (job < 1536 + NCONV) {
      const int j = job - 1024 - NCONV;
      const int level = 15 - (j >> 5), r = j & 31;
      attn_job_abd<M_D>(p, r >> 2, r & 3, level, smem, tid);
    } else {
      const int j = job - 1536 - NCONV;
      int level, r;
      if (j < 192) { level = 15 - j / 32; r = j % 32; }
      else if (j < 1152) { const int jj = j - 192; const int sl = 6 + jj / 96; r = jj % 96; level = (r < 32) ? (15 - sl) : (21 - sl); }
      else { const int jj = j - 1152; const int sl = 16 + jj / 64; r = 32 + jj % 64; level = 21 - sl; }
      if (r >= 64) attn_job_abd<M_A>(p, (r - 64) >> 2, (r - 64) & 3, level, smem, tid);
      else {
        if (!prep_ok) {
          if (tid == 0) {
            const unsigned nx = xb.st[1];
            unsigned sp = 0;
            while (xb_ld(ready) < nx) { __builtin_amdgcn_s_sleep(2); if (++sp > (1u << 22)) break; }
            __builtin_amdgcn_fence(__ATOMIC_ACQUIRE, "agent");
            asm volatile("s_waitcnt vmcnt(0)" ::: "memory");
          }
          __syncthreads();
          prep_ok = true;
        }
        if (r < 32) attn_job_c(p, r >> 2, 4 * level + (r & 3), smem, tid);
        else attn_job_abd<M_B>(p, (r - 32) >> 2, (r - 32) & 3, level, smem, tid);
      }
    }
  }
}

DI void phase_outproj(const Params& p, int l, int bid, int nb, unsigned char* smem, int tid) {
  for (int tile = bid; tile < 128 * 4; tile += nb) { u32x4 xr[4], wq[8]; gemm_big<3, 4>(p, l, tile % 128, tile / 128, smem, launder(tid), xr, wq, false, -1, 0); }
}

DI void phase_post(const Params& p, int l, int bid, int nb, int tid) {
  const int wave = tid >> 6, lane = tid & 63;
  const float* gp = p.g_post + l * 1024;
  for (int row = bid * 4 + wave; row < T_TOK; row += nb * 4) {
    const u16* y = p.proj() + (size_t)row * 1024;
    f32x4 yv[4];
    float ss = 0.f;
#pragma unroll
    for (int c = 0; c < 4; ++c) {
      const u32x2 yb = *(const u32x2*)(y + c * 256 + lane * 4);
      yv[c].x = bflo(yb.x); yv[c].y = bfhi(yb.x); yv[c].z = bflo(yb.y); yv[c].w = bfhi(yb.y);
      ss += yv[c].x * yv[c].x + yv[c].y * yv[c].y + yv[c].z * yv[c].z + yv[c].w * yv[c].w;
    }
#pragma unroll
    for (int off = 32; off >= 1; off >>= 1) ss += __shfl_xor(ss, off, 64);
    const float rs = rsqrtf(ss * (1.0f / 1024.0f) + EPS);
    float ss2 = 0.f;
#pragma unroll
    for (int c = 0; c < 4; ++c) {
      f32x4 xv;
      if (l == 0) xv = *(const f32x4*)(p.x + (size_t)row * 1024 + c * 256 + lane * 4);
      else {
        const u32x2 xb2 = *(const u32x2*)(p.xb() + (size_t)row * 1024 + c * 256 + lane * 4);
        xv.x = bflo(xb2.x); xv.y = bfhi(xb2.x); xv.z = bflo(xb2.y); xv.w = bfhi(xb2.y);
      }
      const f32x4 gv = *(const f32x4*)(gp + c * 256 + lane * 4);
      f32x4 o;
      o.x = xv.x + yv[c].x * rs * gv.x; o.y = xv.y + yv[c].y * rs * gv.y;
      o.z = xv.z + yv[c].z * rs * gv.z; o.w = xv.w + yv[c].w * rs * gv.w;
      if (l == 1) *(f32x4*)(p.out + (size_t)row * 1024 + c * 256 + lane * 4) = o;
      if (l == 0) {
        ss2 += o.x * o.x + o.y * o.y + o.z * o.z + o.w * o.w;
        u32x2 ob; ob.x = pk2(o.x, o.y); ob.y = pk2(o.z, o.w);
        *(u32x2*)(p.xb() + (size_t)row * 1024 + c * 256 + lane * 4) = ob;
      }
    }
    if (l == 0) {
#pragma unroll
      for (int off = 32; off >= 1; off >>= 1) ss2 += __shfl_xor(ss2, off, 64);
      if (lane == 0) p.rstd()[row] = rsqrtf(ss2 * (1.0f / 1024.0f) + EPS);
    }
  }
}

__global__ void __launch_bounds__(256, 2) fwd_megakernel(Params p) {
  __shared__ __attribute__((aligned(16))) unsigned char smem[SMEM_BYTES];
  __shared__ __attribute__((aligned(16))) unsigned xb_words[4];
  cg::grid_group grid = cg::this_grid();
  const int tid = threadIdx.x, bid = blockIdx.x, nb = gridDim.x;
  if (tid == 0) { xb_words[0] = 0u; xb_words[1] = 0u; xb_words[2] = 0u; xb_words[3] = 0u; }
  __syncthreads();
  const XcdBarrier xb = xcd_barrier_post(p.bar(), (volatile LAS unsigned*)xb_words);
  if (p.use_cg) grid.sync();
  phase_init(relaunder(p), bid, nb, launder(tid));
  xcd_barrier_(xb, p.bar());
#pragma unroll 1
  for (int l = 0; l < 2; ++l) {
    phase_inproj(relaunder(p), l, bid, nb, smem, launder(tid));
    xcd_barrier_(xb, p.bar());
    phase_attn(relaunder(p), l, smem, launder(tid), xb);
    xcd_barrier_(xb, p.bar());
    phase_outproj(relaunder(p), l, bid, nb, smem, launder(tid));
    if (nb < 512) {
      xcd_barrier_(xb, p.bar());
      phase_post(relaunder(p), l, bid, nb, launder(tid));
    }
    if (l == 0) xcd_barrier_(xb, p.bar());
  }
}

extern "C" void kernel_launch(void* const* d_in, const int* in_sizes, int n_in, void* d_out, int out_size, void* d_ws,
                              size_t ws_size, hipStream_t stream) {
  Params p{};
  p.x = (const float*)d_in[0];
  p.positions = (const int*)d_in[1];
  p.w_in = (const float*)d_in[2];
  p.w_out = (const float*)d_in[3];
  p.g_pre = (const float*)d_in[4];
  p.g_post = (const float*)d_in[5];
  p.g_q = (const float*)d_in[6];
  p.g_kv = (const float*)d_in[7];
  p.w_uq = (const float*)d_in[8];
  p.w_ukv = (const float*)d_in[9];
  p.pos_k = (const float*)d_in[10];
  p.pos_v = (const float*)d_in[11];
  p.kw1 = (const float*)d_in[12];
  p.kw2 = (const float*)d_in[13];
  p.vw1 = (const float*)d_in[14];
  p.vw2 = (const float*)d_in[15];
  p.out = (float*)d_out;
  p.ws = (char*)d_ws;
  p.use_cg = 0;
  const size_t off = WS_TOTAL;
  if (off > ws_size) { fprintf(stderr, "workspace too small: need %zu have %zu\n", off, ws_size); return; }

  static int grid_blocks = 0;
  if (!grid_blocks) {
    int dev = 0, cus = 0, per_cu = 0;
    hipGetDevice(&dev);
    hipDeviceGetAttribute(&cus, hipDeviceAttributeMultiprocessorCount, dev);
    hipOccupancyMaxActiveBlocksPerMultiprocessor(&per_cu, fwd_megakernel, 256, 0);
    if (per_cu > 2) per_cu = 2;
    if (per_cu < 1) per_cu = 1;
    grid_blocks = cus * per_cu;
  }
  (void)hipMemsetAsync((char*)d_ws + OFF_BAR, 0, SYNC_BYTES, stream);
  void* args[] = {&p};
  hipError_t e = hipLaunchCooperativeKernel((void*)fwd_megakernel, dim3(grid_blocks), dim3(256), args, 0, stream);
  if (e != hipSuccess) fprintf(stderr, "cooperative launch failed: %s (grid %d)\n", hipGetErrorString(e), grid_blocks);
}
```

```cpp
#include <hip/hip_runtime.h>
#include <hip/hip_cooperative_groups.h>
#include <cstdio>
namespace cg = cooperative_groups;

typedef unsigned short u16;
typedef short bf16x8 __attribute__((ext_vector_type(8)));
typedef float f32x16 __attribute__((ext_vector_type(16)));
typedef __bf16 bf2_t __attribute__((ext_vector_type(2)));
typedef float f2_t __attribute__((ext_vector_type(2)));
typedef unsigned u32x4 __attribute__((ext_vector_type(4)));
typedef unsigned u32x2 __attribute__((ext_vector_type(2)));
typedef float f32x4 __attribute__((ext_vector_type(4)));

#define DI __device__ __forceinline__
#define MFMA32(a, b, c) __builtin_amdgcn_mfma_f32_32x32x16_bf16((a), (b), (c), 0, 0, 0)


constexpr int T_TOK = 16384, SEQ = 2048, DM = 1024, NP = 3712, NPW = 3840, NBATCH = 8;
constexpr int CA_Q = 0, CA_K = 256, CA_V = 512, CA_G = 768;
constexpr int CB_CQ = 1024, CB_CKV = 1280, CB_G = 1408;
constexpr int CC_Q = 1664, CC_KC = 1920, CC_VC = 1984, CC_KS = 2048, CC_VS = 2112, CC_KW = 2176, CC_VW = 2240, CC_G = 2304;
constexpr int CD_Q = 2560, CD_K = 2816, CD_V = 3072, CD_G = 3328;
constexpr int C_KR = 3584, C_GL = 3616;
constexpr float EPS = 1e-6f;
constexpr float NEGM = -3.0e38f;
constexpr float MINIT = -1.0e30f;

constexpr int SMEM_BYTES = 74752;
constexpr int L_IMPW = 36864, L_P3W = 53760, L_SELM = 70656, L_SELANY = 70784, L_JOB = 70788;

constexpr size_t al256(size_t x) { return (x + 255) & ~(size_t)255; }
constexpr size_t OFF_WINT = 0;
constexpr size_t OFF_WOUTT = OFF_WINT + al256((size_t)2 * NPW * 1024 * 2);
constexpr size_t OFF_WUQT = OFF_WOUTT + al256((size_t)2 * 1024 * 1024 * 2);
constexpr size_t OFF_WUKVT = OFF_WUQT + al256((size_t)2 * 384 * 256 * 2);
constexpr size_t OFF_W1T = OFF_WUKVT + al256((size_t)2 * 512 * 128 * 2);
constexpr size_t OFF_W2T = OFF_W1T + al256((size_t)4 * 256 * 2048 * 2);
constexpr size_t OFF_C64 = OFF_W2T + al256((size_t)4 * 64 * 256 * 2);
constexpr size_t OFF_S64 = OFF_C64 + al256((size_t)T_TOK * 32 * 4);
constexpr size_t OFF_C32 = OFF_S64 + al256((size_t)T_TOK * 32 * 4);
constexpr size_t OFF_S32 = OFF_C32 + al256((size_t)T_TOK * 16 * 4);
constexpr size_t OFF_XB = OFF_S32 + al256((size_t)T_TOK * 16 * 4);
constexpr size_t OFF_RSTD = OFF_XB + al256((size_t)T_TOK * 1024 * 2);
constexpr size_t OFF_PROJ = OFF_RSTD + al256((size_t)T_TOK * 4);
constexpr size_t OFF_QB = OFF_PROJ + al256((size_t)T_TOK * NP * 2);
constexpr size_t OFF_KB = OFF_QB + al256((size_t)T_TOK * 384 * 2);
constexpr size_t OFF_VB = OFF_KB + al256((size_t)T_TOK * 384 * 2);
constexpr size_t OFF_KC = OFF_VB + al256((size_t)T_TOK * 256 * 2);
constexpr size_t OFF_VC = OFF_KC + al256((size_t)NBATCH * 128 * 64 * 2);
constexpr size_t OFF_MIXED = OFF_VC + al256((size_t)NBATCH * 128 * 64 * 2);
constexpr size_t OFF_BAR = OFF_MIXED + al256((size_t)T_TOK * 1024 * 2);
constexpr size_t SYNC_BYTES = (size_t)3456 * 4 + 256 + 512 * 4;
constexpr size_t OFF_PART = OFF_BAR + al256(SYNC_BYTES);
constexpr size_t WS_TOTAL = OFF_PART + al256((size_t)4 * 128 * 4 * 128 * 4);

struct Params {
  const float *x, *w_in, *w_out, *g_pre, *g_post, *g_q, *g_kv, *w_uq, *w_ukv, *pos_k, *pos_v, *kw1, *kw2, *vw1, *vw2;
  const int* positions;
  float* out;
  char* ws;
  long long use_cg;
  DI u16* WinT() const { return (u16*)(ws + OFF_WINT); }
  DI u16* WoutT() const { return (u16*)(ws + OFF_WOUTT); }
  DI u16* WuqT() const { return (u16*)(ws + OFF_WUQT); }
  DI u16* WukvT() const { return (u16*)(ws + OFF_WUKVT); }
  DI u16* W1T() const { return (u16*)(ws + OFF_W1T); }
  DI u16* W2T() const { return (u16*)(ws + OFF_W2T); }
  DI float* c64() const { return (float*)(ws + OFF_C64); }
  DI float* s64() const { return (float*)(ws + OFF_S64); }
  DI float* c32() const { return (float*)(ws + OFF_C32); }
  DI float* s32() const { return (float*)(ws + OFF_S32); }
  DI u16* xb() const { return (u16*)(ws + OFF_XB); }
  DI u16* mixed() const { return (u16*)(ws + OFF_MIXED); }
  DI float* rstd() const { return (float*)(ws + OFF_RSTD); }
  DI u16* proj() const { return (u16*)(ws + OFF_PROJ); }
  DI u16* qB() const { return (u16*)(ws + OFF_QB); }
  DI u16* kB() const { return (u16*)(ws + OFF_KB); }
  DI u16* vB() const { return (u16*)(ws + OFF_VB); }
  DI u16* kc() const { return (u16*)(ws + OFF_KC); }
  DI u16* vc() const { return (u16*)(ws + OFF_VC); }
  DI unsigned* bar() const { return (unsigned*)(ws + OFF_BAR); }
  DI int* ctr() const { return (int*)(ws + OFF_BAR) + 3456; }
  DI unsigned* xcnt() const { return (unsigned*)(ws + OFF_BAR) + 3456 + 64; }
  DI float* xpart() const { return (float*)(ws + OFF_PART); }
};

DI unsigned pk2(float a, float b) {
  bf2_t r = __builtin_convertvector((f2_t){a, b}, bf2_t);
  return __builtin_bit_cast(unsigned, r);
}
DI float bflo(unsigned v) { return __uint_as_float(v << 16); }
DI float bfhi(unsigned v) { return __uint_as_float(v & 0xffff0000u); }
DI float bf2f(u16 v) { return __uint_as_float(((unsigned)v) << 16); }
DI u16 f2bf(float a) { return (u16)(pk2(a, 0.f) & 0xffffu); }
DI float sigmoidf_(float x) { return 1.0f / (1.0f + __expf(-x)); }
DI float siluf_(float x) { return x / (1.0f + __expf(-x)); }
DI bf16x8 pack8(float a0, float a1, float a2, float a3, float a4, float a5, float a6, float a7) {
  u32x4 u; u.x = pk2(a0, a1); u.y = pk2(a2, a3); u.z = pk2(a4, a5); u.w = pk2(a6, a7);
  return __builtin_bit_cast(bf16x8, u);
}
DI bf16x8 ld2x8(const u16* p0, const u16* p1) {
  const u32x2 a = *(const u32x2*)p0, b = *(const u32x2*)p1;
  u32x4 u; u.x = a.x; u.y = a.y; u.z = b.x; u.w = b.y;
  return __builtin_bit_cast(bf16x8, u);
}
DI Params relaunder(Params q) { asm volatile("" : "+s"(q.ws)); return q; }
DI int launder(int v) { asm volatile("" : "+v"(v)); return v; }
DI float xor32(float v) { return __shfl_xor(v, 32, 64); }


#define XB_TMO      128
#define XB_XCNT(j)  (256  + 64 * (j))
#define XB_XSUB(j)  (1280 + 64 * (j))
#define XB_XGEN(j)  (2304 + 64 * (j))
#define XB_TOP      3328
#define XB_TOPGEN   3392
#define XCD_BAR_WORDS 3456
#define XB_SPIN_CAP (1u << 20)
#define LAS __attribute__((address_space(3)))
DI unsigned xb_ld(unsigned* p) { return __hip_atomic_load(p, __ATOMIC_RELAXED, __HIP_MEMORY_SCOPE_AGENT); }
DI unsigned xb_add(unsigned* p, unsigned v) { return __hip_atomic_fetch_add(p, v, __ATOMIC_RELAXED, __HIP_MEMORY_SCOPE_AGENT); }
DI unsigned xb_xcc_id() { return (unsigned)__builtin_amdgcn_s_getreg((3 << 11) | 20) & 0xFu; }
#define XB_SPIN(cond, bar) do { unsigned _sp = 0; while (cond) { __builtin_amdgcn_s_sleep(1); \
    if ((++_sp & 255u) == 0u) { if (xb_ld(&(bar)[XB_TMO])) break; if (_sp > XB_SPIN_CAP) { atomicAdd(&(bar)[XB_TMO], 1u); break; } } } } while (0)
struct XcdBarrier { volatile LAS unsigned* st; };
DI XcdBarrier xcd_barrier_post(unsigned* bar, volatile LAS unsigned* st) {
  XcdBarrier b; b.st = st;
  if (threadIdx.x == 0) { const unsigned x = xb_xcc_id(); st[2] = x; (void)xb_add(&bar[XB_XCNT(x)], 1u); }
  return b;
}
DI void xcd_barrier_complete(unsigned* bar, unsigned x, unsigned& nloc, unsigned& nx) {
  const unsigned G = gridDim.x * gridDim.y * gridDim.z;
  unsigned sum, cnt, mine, sp = 0u;
  for (;;) {
    sum = 0u; cnt = 0u; mine = 0u;
#pragma unroll
    for (unsigned j = 0; j < 16; ++j) { const unsigned c = xb_ld(&bar[XB_XCNT(j)]); sum += c; cnt += (c > 0u) ? 1u : 0u; mine = (j == x) ? c : mine; }
    if (sum == G) break;
    __builtin_amdgcn_s_sleep(1);
    if ((++sp & 255u) == 0u) { if (xb_ld(&bar[XB_TMO])) break; if (sp > XB_SPIN_CAP) { atomicAdd(&bar[XB_TMO], 1u); break; } }
  }
  nloc = mine > 0u ? mine : 1u; nx = cnt > 0u ? cnt : 1u;
}
DI void xcd_barrier_(const XcdBarrier& b, unsigned* bar) {
  asm volatile("s_waitcnt vmcnt(0)" ::: "memory");
  __syncthreads();
  if (threadIdx.x == 0) {
    __builtin_amdgcn_s_waitcnt(0);
    unsigned nloc = b.st[0], nx = b.st[1];
    const unsigned bx = b.st[2];
    if (nloc == 0u) { xcd_barrier_complete(bar, bx, nloc, nx); b.st[0] = nloc; b.st[1] = nx; }
    const unsigned old = xb_add(&bar[XB_XSUB(bx)], 1u);
    const unsigned gen = old / nloc;
    if (old + 1u == (gen + 1u) * nloc) {
      __builtin_amdgcn_fence(__ATOMIC_RELEASE, "agent");
      asm volatile("s_waitcnt vmcnt(0)" ::: "memory");
      const unsigned og = xb_add(&bar[XB_TOP], 1u);
      const unsigned tg = og / nx;
      if (og + 1u == (tg + 1u) * nx) xb_add(&bar[XB_TOPGEN], 1u);
      else XB_SPIN(xb_ld(&bar[XB_TOPGEN]) == tg, bar);
      __builtin_amdgcn_fence(__ATOMIC_ACQUIRE, "agent");
      xb_add(&bar[XB_XGEN(bx)], 1u);
      asm volatile("s_waitcnt vmcnt(0)" ::: "memory");
    } else {
      XB_SPIN(xb_ld(&bar[XB_XGEN(bx)]) == gen, bar);
      __builtin_amdgcn_fence(__ATOMIC_ACQUIRE, "agent");
      asm volatile("s_waitcnt vmcnt(0)" ::: "memory");
    }
  }
  __syncthreads();
}

DI int inproj_colmap(int n) {
  if (n < 1408) return n;
  if (n < 2304) return n + 32;
  if (n < 3584) return n + 44;
  if (n < 3616) return 1408 + (n - 3584);
  if (n < 3628) return 2336 + (n - 3616);
  return -1;
}

template <bool INPROJ, bool FRAG>
DI void convT(u16* __restrict__ dst, const float* __restrict__ src, const float* __restrict__ rowscale, int K, int Nsrc,
              int Ndst, int gtid, int gsz) {
  const int kch = K >> 3;
  const int n4 = Ndst >> 2;
  const int total = n4 * kch;
  for (int idx = gtid; idx < total; idx += gsz) {
    const int n = (idx % n4) * 4, kc = idx / n4;
    const int sc = INPROJ ? inproj_colmap(n) : n;
    f32x4 v[8];
#pragma unroll
    for (int e = 0; e < 8; ++e) {
      const int k = kc * 8 + e;
      f32x4 w = {0.f, 0.f, 0.f, 0.f};
      if (sc >= 0) {
        w = *(const f32x4*)(src + (size_t)k * Nsrc + sc);
        if (rowscale) { const float rsn = rowscale[k]; w.x *= rsn; w.y *= rsn; w.z *= rsn; w.w *= rsn; }
      }
      v[e] = w;
    }
#pragma unroll
    for (int c = 0; c < 4; ++c) {
      u32x4 o;
      o.x = pk2(v[0][c], v[1][c]); o.y = pk2(v[2][c], v[3][c]); o.z = pk2(v[4][c], v[5][c]); o.w = pk2(v[6][c], v[7][c]);
      const int nn = n + c;
      if (FRAG) *(u32x4*)(dst + ((size_t)((nn >> 5) * (K >> 4) + (kc >> 1)) * 64 + (kc & 1) * 32 + (nn & 31)) * 8) = o;
      else *(u32x4*)(dst + (size_t)nn * K + kc * 8) = o;
    }
  }
}

DI void row_pre(const float* __restrict__ xr, u16* __restrict__ xbr, float* __restrict__ rstd_out, int lane) {
  float ss = 0.f;
#pragma unroll
  for (int c = 0; c < 4; ++c) {
    const f32x4 v = *(const f32x4*)(xr + c * 256 + lane * 4);
    ss += v.x * v.x + v.y * v.y + v.z * v.z + v.w * v.w;
    u32x2 o; o.x = pk2(v.x, v.y); o.y = pk2(v.z, v.w);
    *(u32x2*)(xbr + c * 256 + lane * 4) = o;
  }
#pragma unroll
  for (int off = 32; off >= 1; off >>= 1) ss += __shfl_xor(ss, off, 64);
  if (lane == 0) *rstd_out = rsqrtf(ss * (1.0f / 1024.0f) + EPS);
}

DI void conv_weights(const Params& p, int set, int gtid, int gsz) {
  for (int l = 0; l < 2; ++l) {
    if (set == 1) convT<false, true>(p.WoutT() + (size_t)l * 1024 * 1024, p.w_out + (size_t)l * 1024 * 1024, nullptr, 1024, 1024, 1024, gtid, gsz);
    if (l != set) continue;
    convT<true, true>(p.WinT() + (size_t)l * NPW * 1024, p.w_in + (size_t)l * 1024 * 3628, p.g_pre + l * 1024, 1024, 3628, NPW, gtid, gsz);
    convT<false, false>(p.WuqT() + (size_t)l * 384 * 256, p.w_uq + (size_t)l * 256 * 384, p.g_q + l * 256, 256, 384, 384, gtid, gsz);
    convT<false, false>(p.WukvT() + (size_t)l * 512 * 128, p.w_ukv + (size_t)l * 128 * 512, p.g_kv + l * 128, 128, 512, 512, gtid, gsz);
    convT<false, true>(p.W1T() + (size_t)(l * 2 + 0) * 256 * 2048, p.kw1 + (size_t)l * 2048 * 256, nullptr, 2048, 256, 256, gtid, gsz);
    convT<false, true>(p.W1T() + (size_t)(l * 2 + 1) * 256 * 2048, p.vw1 + (size_t)l * 2048 * 256, nullptr, 2048, 256, 256, gtid, gsz);
    convT<false, false>(p.W2T() + (size_t)(l * 2 + 0) * 64 * 256, p.kw2 + (size_t)l * 256 * 64, nullptr, 256, 64, 64, gtid, gsz);
    convT<false, false>(p.W2T() + (size_t)(l * 2 + 1) * 64 * 256, p.vw2 + (size_t)l * 256 * 64, nullptr, 256, 64, 64, gtid, gsz);
  }
}

DI void phase_init(const Params& p, int bid, int nb, int tid) {
  const int gtid = bid * 256 + tid, gsz = nb * 256;
  conv_weights(p, 0, gtid, gsz);
  for (int idx = gtid; idx < T_TOK * 48; idx += gsz) {
    const int t = idx / 48, i = idx % 48;
    const float posf = (float)p.positions[t];
    float inv;
    if (i < 32) inv = (float)exp2(-(double)i * (13.287712379549449 / 32.0));
    else inv = (float)exp2(-(double)(i - 32) * (13.287712379549449 / 16.0));
    const float ang = posf * inv;
    const float rev = ang * 0.15915494309189535f;
    const float fr = rev - floorf(rev);
    const float sn = __builtin_amdgcn_sinf(fr), cs = __builtin_amdgcn_cosf(fr);
    if (i < 32) ((unsigned*)p.c64())[t * 32 + i] = pk2(cs, sn);
    else { p.c32()[t * 16 + i - 32] = cs; p.s32()[t * 16 + i - 32] = sn; }
  }
  for (int idx = gtid; idx < NBATCH * 64; idx += gsz) {
    const int b = idx >> 6, d = idx & 63;
    p.kc()[(b * 128 + 127) * 64 + d] = 0;
    p.vc()[(b * 128 + 127) * 64 + d] = 0;
  }
  const int wave = tid >> 6, lane = tid & 63;
  for (int row = bid * 4 + wave; row < T_TOK; row += nb * 4)
    row_pre(p.x + (size_t)row * 1024, p.xb() + (size_t)row * 1024, p.rstd() + row, lane);
}

DI void store4(u16* dst, float a, float b, float c, float d) {
  u32x2 o; o.x = pk2(a, b); o.y = pk2(c, d);
  *(u32x2*)dst = o;
}

typedef __attribute__((address_space(1))) unsigned long long gu64;
DI void store4_wt(u16* dst, float a, float b, float c, float d) {
  const unsigned long long v = (unsigned long long)pk2(a, b) | ((unsigned long long)pk2(c, d) << 32);
  __hip_atomic_store((gu64*)dst, v, __ATOMIC_RELAXED, __HIP_MEMORY_SCOPE_AGENT);
}

DI void store8_pair(u16* dst, float a0, float a1, float a2, float a3, float b0, float b1, float b2, float b3, int h) {
  unsigned ax = pk2(a0, a1), ay = pk2(a2, a3), bx = pk2(b0, b1), by = pk2(b2, b3);
  auto rx = __builtin_amdgcn_permlane32_swap(ax, bx, false, false);
  auto ry = __builtin_amdgcn_permlane32_swap(ay, by, false, false);
  u32x4 o; o.x = rx[0]; o.y = ry[0]; o.z = rx[1]; o.w = ry[1];
  *(u32x4*)(dst + (h ? 8 : 0)) = o;
}

DI void load8_pair(const u16* src, int h, u32x2& ga, u32x2& gb) {
  const u32x4 v = *(const u32x4*)(src + (h ? 8 : 0));
  auto rx = __builtin_amdgcn_permlane32_swap(v.x, v.z, false, false);
  auto ry = __builtin_amdgcn_permlane32_swap(v.y, v.w, false, false);
  ga.x = rx[0]; ga.y = ry[0]; gb.x = rx[1]; gb.y = ry[1];
}

template <int MODE>
DI void gemm128(const Params& p, int l, int mt, int nt, unsigned char* smem, int tid) {
  const int lane = tid & 63, wave = tid >> 6, r31 = lane & 31, h = lane >> 5;
  const int wn = wave & 1, wt = wave >> 1;
  const int m0 = mt * 128, n0 = nt * 128;
  const u16* A; const u16* W; int lda, K;
  if (MODE == 0) { A = p.xb(); lda = 1024; K = 1024; W = p.WinT() + (size_t)l * NPW * 1024; }
  else if (MODE == 1) { A = p.proj() + CB_CQ; lda = NP; K = 256; W = p.WuqT() + (size_t)l * 384 * 256; }
  else if (MODE == 2) { A = p.proj() + CB_CKV; lda = NP; K = 128; W = p.WukvT() + (size_t)l * 512 * 128; }
  else { A = p.xb(); lda = 1024; K = 1024; W = p.WoutT() + (size_t)l * 1024 * 1024; }
  float* rs_s = (float*)(smem + 73728);

  __syncthreads();
  if (MODE == 1 || MODE == 2) {
    const int row = tid >> 1, half = tid & 1;
    const u16* ar = A + (size_t)(m0 + row) * lda + half * (K >> 1);
    float ss = 0.f;
    for (int c = 0; c < (K >> 4); ++c) {
      const u32x4 v = *(const u32x4*)(ar + c * 8);
      float f;
      f = bflo(v.x); ss += f * f; f = bfhi(v.x); ss += f * f;
      f = bflo(v.y); ss += f * f; f = bfhi(v.y); ss += f * f;
      f = bflo(v.z); ss += f * f; f = bfhi(v.z); ss += f * f;
      f = bflo(v.w); ss += f * f; f = bfhi(v.w); ss += f * f;
    }
    ss += __shfl_xor(ss, 1, 64);
    if (half == 0) rs_s[row] = rsqrtf(ss / (float)K + EPS);
  }

  f32x16 acc[2][2];
#pragma unroll
  for (int a = 0; a < 2; ++a)
#pragma unroll
    for (int b = 0; b < 2; ++b)
#pragma unroll
      for (int i = 0; i < 16; ++i) acc[a][b][i] = 0.f;

  const int KT = K >> 6;
  const int lrow = tid >> 3, lch = tid & 7;
  u32x4 xa[4], wa[4], xc[4], wc[4];
#define G_LOAD(XS, WS, KTI) { _Pragma("unroll") for (int rep = 0; rep < 4; ++rep) { \
      XS[rep] = *(const u32x4*)(A + (size_t)(m0 + lrow + rep * 32) * lda + (KTI) * 64 + lch * 8); \
      WS[rep] = *(const u32x4*)(W + (size_t)(n0 + lrow + rep * 32) * K + (KTI) * 64 + lch * 8); } }
#define G_STORE(XS, WS, BUF) { _Pragma("unroll") for (int rep = 0; rep < 4; ++rep) { \
      *(u32x4*)((u16*)(smem + (BUF) * 36864) + (lrow + rep * 32) * 72 + lch * 8) = XS[rep]; \
      *(u32x4*)((u16*)(smem + (BUF) * 36864 + 18432) + (lrow + rep * 32) * 72 + lch * 8) = WS[rep]; } }
#define G_COMPUTE(BUF) { const u16* Xb = (const u16*)(smem + (BUF) * 36864); const u16* Wb = (const u16*)(smem + (BUF) * 36864 + 18432); \
    _Pragma("unroll") for (int ks = 0; ks < 4; ++ks) { \
      bf16x8 wf[2], xf[2]; \
      _Pragma("unroll") for (int a = 0; a < 2; ++a) wf[a] = *(const bf16x8*)(Wb + (wn * 64 + a * 32 + r31) * 72 + ks * 16 + h * 8); \
      _Pragma("unroll") for (int b = 0; b < 2; ++b) xf[b] = *(const bf16x8*)(Xb + (wt * 64 + b * 32 + r31) * 72 + ks * 16 + h * 8); \
      _Pragma("unroll") for (int a = 0; a < 2; ++a) \
        _Pragma("unroll") for (int b = 0; b < 2; ++b) acc[a][b] = MFMA32(wf[a], xf[b], acc[a][b]); } }
  G_LOAD(xa, wa, 0);
  if (KT > 1) G_LOAD(xc, wc, 1);
  G_STORE(xa, wa, 0);
  __syncthreads();
  for (int kt = 0; kt < KT; kt += 2) {
    if (kt + 2 < KT) G_LOAD(xa, wa, kt + 2);
    G_COMPUTE(0);
    if (kt + 1 < KT) G_STORE(xc, wc, 1);
    __syncthreads();
    if (kt + 1 >= KT) break;
    if (kt + 3 < KT) G_LOAD(xc, wc, kt + 3);
    G_COMPUTE(1);
    if (kt + 2 < KT) G_STORE(xa, wa, 0);
    __syncthreads();
  }

  const int nbw = n0 + wn * 64;
#pragma unroll
  for (int b = 0; b < 2; ++b) {
    const int trow = wt * 64 + b * 32 + r31;
    const int tok = m0 + trow;
    if (MODE == 0) {
      const float rs = p.rstd()[tok];
      const bool rope = (nbw < 512) || (nbw >= 1664 && nbw < 1984) || (nbw == 2048) || (nbw == 2176);
      u16* dst = p.proj() + (size_t)tok * NP + nbw;
      if (rope) {
#pragma unroll
        for (int g = 0; g < 4; ++g) {
          const f32x4 cs = *(const f32x4*)(p.c64() + tok * 32 + 8 * g + 4 * h);
          const f32x4 sn = *(const f32x4*)(p.s64() + tok * 32 + 8 * g + 4 * h);
          const float x10 = acc[0][b][4 * g + 0] * rs, x11 = acc[0][b][4 * g + 1] * rs, x12 = acc[0][b][4 * g + 2] * rs, x13 = acc[0][b][4 * g + 3] * rs;
          const float x20 = acc[1][b][4 * g + 0] * rs, x21 = acc[1][b][4 * g + 1] * rs, x22 = acc[1][b][4 * g + 2] * rs, x23 = acc[1][b][4 * g + 3] * rs;
          store4(dst + 8 * g + 4 * h, x10 * cs.x - x20 * sn.x, x11 * cs.y - x21 * sn.y, x12 * cs.z - x22 * sn.z, x13 * cs.w - x23 * sn.w);
          store4(dst + 32 + 8 * g + 4 * h, x10 * sn.x + x20 * cs.x, x11 * sn.y + x21 * cs.y, x12 * sn.z + x22 * cs.z, x13 * sn.w + x23 * cs.w);
        }
      } else {
#pragma unroll
        for (int a = 0; a < 2; ++a)
#pragma unroll
          for (int g = 0; g < 4; ++g)
            store4(dst + a * 32 + 8 * g + 4 * h, acc[a][b][4 * g] * rs, acc[a][b][4 * g + 1] * rs, acc[a][b][4 * g + 2] * rs, acc[a][b][4 * g + 3] * rs);
      }
    } else if (MODE == 1) {
      const float rs = rs_s[trow];
#pragma unroll
      for (int a = 0; a < 2; ++a) {
        const int nsub = nbw + a * 32;
        u16* dst = p.qB() + (size_t)tok * 384 + nsub;
        float v[16];
#pragma unroll
        for (int i = 0; i < 16; ++i) v[i] = acc[a][b][i] * rs;
        if (((nsub >> 5) % 3) == 2) {
#pragma unroll
          for (int g = 0; g < 2; ++g) {
            const f32x4 cs = *(const f32x4*)(p.c32() + tok * 16 + 8 * g + 4 * h);
            const f32x4 sn = *(const f32x4*)(p.s32() + tok * 16 + 8 * g + 4 * h);
            const float c_[4] = {cs.x, cs.y, cs.z, cs.w};
            const float s_[4] = {sn.x, sn.y, sn.z, sn.w};
#pragma unroll
            for (int r = 0; r < 4; ++r) {
              const float x1 = v[4 * g + r], x2 = v[8 + 4 * g + r];
              v[4 * g + r] = x1 * c_[r] - x2 * s_[r];
              v[8 + 4 * g + r] = x1 * s_[r] + x2 * c_[r];
            }
          }
        }
#pragma unroll
        for (int gq = 0; gq < 2; ++gq) store8_pair(dst + 16 * gq, v[8 * gq], v[8 * gq + 1], v[8 * gq + 2], v[8 * gq + 3], v[8 * gq + 4], v[8 * gq + 5], v[8 * gq + 6], v[8 * gq + 7], h);
      }
    } else if (MODE == 2) {
      const float rs = rs_s[trow];
      const int head = nbw >> 7, part = (nbw >> 6) & 1;
      u16* dst = part ? (p.vB() + (size_t)tok * 256 + head * 64) : (p.kB() + (size_t)tok * 384 + head * 96);
#pragma unroll
      for (int a = 0; a < 2; ++a)
#pragma unroll
        for (int gq = 0; gq < 2; ++gq)
          store8_pair(dst + a * 32 + 16 * gq, acc[a][b][8 * gq] * rs, acc[a][b][8 * gq + 1] * rs, acc[a][b][8 * gq + 2] * rs, acc[a][b][8 * gq + 3] * rs,
                      acc[a][b][8 * gq + 4] * rs, acc[a][b][8 * gq + 5] * rs, acc[a][b][8 * gq + 6] * rs, acc[a][b][8 * gq + 7] * rs, h);
    } else {
      float* y = (float*)p.proj() + (size_t)tok * 1024 + nbw;
#pragma unroll
      for (int a = 0; a < 2; ++a)
#pragma unroll
        for (int g = 0; g < 4; ++g) {
          f32x4 o; o.x = acc[a][b][4 * g]; o.y = acc[a][b][4 * g + 1]; o.z = acc[a][b][4 * g + 2]; o.w = acc[a][b][4 * g + 3];
          *(f32x4*)(y + a * 32 + 8 * g + 4 * h) = o;
        }
    }
  }
}


DI void row_exchange(float* part_s, float* tot_s, float* pg  , unsigned* cntp, int nt, int tid) {
  __syncthreads();
  if (tid < 128) {
    const float t = (part_s[tid] + part_s[128 + tid]) + (part_s[256 + tid] + part_s[384 + tid]);
    __hip_atomic_store((unsigned*)(pg + nt * 128 + tid), __float_as_uint(t), __ATOMIC_RELAXED, __HIP_MEMORY_SCOPE_AGENT);
  }
  asm volatile("s_waitcnt vmcnt(0)" ::: "memory");
  __syncthreads();
  if (tid == 0) {
    (void)xb_add(cntp, 1u);
    unsigned sp = 0;
    while (xb_ld(cntp) < 4u) { __builtin_amdgcn_s_sleep(1); if (++sp > (1u << 22)) break; }
    __builtin_amdgcn_fence(__ATOMIC_ACQUIRE, "agent");
    asm volatile("s_waitcnt vmcnt(0)" ::: "memory");
  }
  __syncthreads();
  if (tid < 128) {
    float t[4];
#pragma unroll
    for (int q = 0; q < 4; ++q) t[q] = __uint_as_float(__hip_atomic_load((unsigned*)(pg + q * 128 + tid), __ATOMIC_RELAXED, __HIP_MEMORY_SCOPE_AGENT));
    tot_s[tid] = (t[0] + t[1]) + (t[2] + t[3]);
  }
  __syncthreads();
}

template <int MODE, int NB = 4>
DI void gemm_big(const Params& p, int l, int mt, int nt, unsigned char* smem, int tid, u32x4 (&xr)[NB], u32x4 (&wq)[8], bool pre, int nmt, int nnt) {
  const int lane = tid & 63, wave = tid >> 6, r31 = lane & 31, h = lane >> 5;
  const int m0 = mt * (NB * 32), n0 = nt * 256;
  const u16* A = (MODE == 0) ? p.xb() : p.mixed();
  const u16* W = (MODE == 0) ? (p.WinT() + (size_t)l * NPW * 1024) : (p.WoutT() + (size_t)l * 1024 * 1024);
  f32x16 acc[2][NB];
#pragma unroll
  for (int a = 0; a < 2; ++a)
#pragma unroll
    for (int b = 0; b < NB; ++b)
#pragma unroll
      for (int i = 0; i < 16; ++i) acc[a][b][i] = 0.f;
  const int lrow = tid >> 3, lch = tid & 7;
  const u16* Wf = W + ((size_t)((n0 >> 5) + wave * 2) * 64 * 64 + lane) * 8;
  const char* Abase = (const char*)(A + (size_t)m0 * 1024);
  const unsigned xoff = (unsigned)((lrow * 1024 + lch * 8) * 2);
#define GB_XLOAD(KTI) { _Pragma("unroll") for (int rep = 0; rep < NB; ++rep) xr[rep] = *(const u32x4*)(Abase + (size_t)(rep * 65536 + (KTI) * 128) + xoff); }
#define GB_XSTORE(BUF) { _Pragma("unroll") for (int rep = 0; rep < NB; ++rep) *(u32x4*)((u16*)(smem + (BUF) * 18432) + (lrow + rep * 32) * 72 + lch * 8) = xr[rep]; }
#define GB_WLD(A_, KS_, KTI) (*(const u32x4*)(Wf + (size_t)((A_) * 64 + (KTI) * 4 + (KS_)) * 512))
#define GB_XFRAG(XF, KS_) { _Pragma("unroll") for (int b = 0; b < NB; ++b) XF[b] = *(const bf16x8*)(Xb + (b * 32 + r31) * 72 + (KS_) * 16 + h * 8); }
#define GB_KS(XC, KS_, KTI) { \
    __builtin_amdgcn_s_setprio(2); \
    _Pragma("unroll") for (int a = 0; a < 2; ++a) { \
      _Pragma("unroll") for (int b = 0; b < NB; ++b) acc[a][b] = MFMA32(__builtin_bit_cast(bf16x8, wq[a * 4 + (KS_)]), XC[b], acc[a][b]); \
      if ((KTI) + 1 < 16) wq[a * 4 + (KS_)] = GB_WLD(a, (KS_), (KTI) + 1); } \
    __builtin_amdgcn_s_setprio(0); \
    __builtin_amdgcn_sched_barrier(0); }
#define GB_COMPUTE(BUF, KTI) { const u16* Xb = (const u16*)(smem + (BUF) * 18432); \
    bf16x8 xfa[NB], xfb[NB]; \
    GB_XFRAG(xfa, 0); GB_XFRAG(xfb, 1); GB_KS(xfa, 0, KTI); \
    GB_XFRAG(xfa, 2); GB_KS(xfb, 1, KTI); \
    GB_XFRAG(xfb, 3); GB_KS(xfa, 2, KTI); \
    GB_KS(xfb, 3, KTI); }
  __syncthreads();
  if (!pre) {
    GB_XLOAD(0);
#pragma unroll
    for (int a = 0; a < 2; ++a)
#pragma unroll
      for (int ks = 0; ks < 4; ++ks) wq[a * 4 + ks] = GB_WLD(a, ks, 0);
  }
  GB_XSTORE(0);
  GB_XLOAD(1);
  __syncthreads();
  for (int kt = 0; kt < 16; kt += 2) {
    GB_COMPUTE(0, kt);
    GB_XSTORE(1);
    if (kt + 2 < 16) GB_XLOAD(kt + 2);
    __syncthreads();
    GB_COMPUTE(1, kt + 1);
    if (kt + 2 < 16) { GB_XSTORE(0); }
    if (kt + 3 < 16) GB_XLOAD(kt + 3);
    __syncthreads();
  }
  if (nmt >= 0) {
    const char* AbaseN = (const char*)(A + (size_t)nmt * (NB * 32) * 1024);
    const u16* WfN = W + ((size_t)((nnt * 256 >> 5) + wave * 2) * 64 * 64 + lane) * 8;
#pragma unroll
    for (int rep = 0; rep < NB; ++rep) xr[rep] = *(const u32x4*)(AbaseN + (size_t)(rep * 65536) + xoff);
#pragma unroll
    for (int a = 0; a < 2; ++a)
#pragma unroll
      for (int ks = 0; ks < 4; ++ks) wq[a * 4 + ks] = *(const u32x4*)(WfN + (size_t)(a * 64 + ks) * 512);
  }
  const int nbw = n0 + wave * 64;
  const bool FUSE_POST = (MODE == 3) && (gridDim.x >= 512u);
  if (MODE == 0 && nbw >= NP) return;
#pragma unroll
  for (int b = 0; b < NB; ++b) {
    const int tok = m0 + b * 32 + r31;
    if (MODE == 0) {
      const float rs = p.rstd()[tok];
      const bool rope = (nbw < 512) || (nbw >= 1664 && nbw < 1984) || (nbw == 2048) || (nbw == 2176);
      u16* dst = p.proj() + (size_t)tok * NP + nbw;
      if (rope) {
#pragma unroll
        for (int gp = 0; gp < 2; ++gp) {
          float lo[8], hi[8];
#pragma unroll
          for (int u = 0; u < 2; ++u) {
            const int g = 2 * gp + u;
            const u32x4 csv = *(const u32x4*)((const unsigned*)p.c64() + tok * 32 + 8 * g + 4 * h);
            const float c_[4] = {bflo(csv.x), bflo(csv.y), bflo(csv.z), bflo(csv.w)};
            const float s_[4] = {bfhi(csv.x), bfhi(csv.y), bfhi(csv.z), bfhi(csv.w)};
#pragma unroll
            for (int r = 0; r < 4; ++r) {
              const float x1 = acc[0][b][4 * g + r] * rs, x2 = acc[1][b][4 * g + r] * rs;
              lo[4 * u + r] = x1 * c_[r] - x2 * s_[r];
              hi[4 * u + r] = x1 * s_[r] + x2 * c_[r];
            }
          }
          store8_pair(dst + 16 * gp, lo[0], lo[1], lo[2], lo[3], lo[4], lo[5], lo[6], lo[7], h);
          store8_pair(dst + 32 + 16 * gp, hi[0], hi[1], hi[2], hi[3], hi[4], hi[5], hi[6], hi[7], h);
        }
      } else {
#pragma unroll
        for (int a = 0; a < 2; ++a)
#pragma unroll
          for (int gp = 0; gp < 2; ++gp)
            store8_pair(dst + a * 32 + 16 * gp, acc[a][b][8 * gp] * rs, acc[a][b][8 * gp + 1] * rs, acc[a][b][8 * gp + 2] * rs, acc[a][b][8 * gp + 3] * rs,
                        acc[a][b][8 * gp + 4] * rs, acc[a][b][8 * gp + 5] * rs, acc[a][b][8 * gp + 6] * rs, acc[a][b][8 * gp + 7] * rs, h);
      }
    } else if (!FUSE_POST) {
      u16* y = p.proj() + (size_t)tok * 1024 + nbw;
#pragma unroll
      for (int a = 0; a < 2; ++a)
#pragma unroll
        for (int g = 0; g < 4; ++g)
          store4(y + a * 32 + 8 * g + 4 * h, acc[a][b][4 * g], acc[a][b][4 * g + 1], acc[a][b][4 * g + 2], acc[a][b][4 * g + 3]);
    }
  }
  if (MODE == 3 && FUSE_POST) {
    float* part_s = (float*)smem;
    float* tot_s = (float*)(smem + 2048);
    float* pg0 = p.xpart() + ((size_t)((l * 2 + 0) * 128 + mt) * 4) * 128;
    float* pg1 = p.xpart() + ((size_t)((l * 2 + 1) * 128 + mt) * 4) * 128;
    unsigned* c0 = p.xcnt() + (l * 2 + 0) * 128 + mt;
    unsigned* c1 = p.xcnt() + (l * 2 + 1) * 128 + mt;
#pragma unroll
    for (int b = 0; b < NB; ++b) {
      float ss = 0.f;
#pragma unroll
      for (int a = 0; a < 2; ++a)
#pragma unroll
        for (int i = 0; i < 16; ++i) ss += acc[a][b][i] * acc[a][b][i];
      ss += xor32(ss);
      if (h == 0) part_s[wave * 128 + b * 32 + r31] = ss;
    }
    row_exchange(part_s, tot_s, pg0, c0, nt, tid);
    const float* gp = p.g_post + l * 1024 + nbw;
    float ss2[4];
#pragma unroll
    for (int b = 0; b < NB; ++b) {
      const int tok = m0 + b * 32 + r31;
      const float rs = rsqrtf(tot_s[b * 32 + r31] * (1.0f / 1024.0f) + EPS);
      float s2 = 0.f;
#pragma unroll
      for (int a = 0; a < 2; ++a)
#pragma unroll
        for (int gq = 0; gq < 2; ++gq) {
          f32x4 ov[2];
          u32x2 xg[2];
          load8_pair(p.xb() + (size_t)tok * 1024 + nbw + a * 32 + 16 * gq, h, xg[0], xg[1]);
#pragma unroll
          for (int u = 0; u < 2; ++u) {
            const int g = 2 * gq + u;
            const int c = a * 32 + 8 * g + 4 * h;
            const f32x4 gv = *(const f32x4*)(gp + c);
            f32x4 xv;
            {
              const u32x2 xb2 = xg[u];
              xv.x = bflo(xb2.x); xv.y = bfhi(xb2.x); xv.z = bflo(xb2.y); xv.w = bfhi(xb2.y);
            }
            f32x4 o;
            o.x = xv.x + acc[a][b][4 * g] * rs * gv.x; o.y = xv.y + acc[a][b][4 * g + 1] * rs * gv.y;
            o.z = xv.z + acc[a][b][4 * g + 2] * rs * gv.z; o.w = xv.w + acc[a][b][4 * g + 3] * rs * gv.w;
            if (l == 1) *(f32x4*)(p.out + (size_t)tok * 1024 + nbw + c) = o;
            else s2 += o.x * o.x + o.y * o.y + o.z * o.z + o.w * o.w;
            ov[u] = o;
          }
          if (l == 0) store8_pair(p.xb() + (size_t)tok * 1024 + nbw + a * 32 + 16 * gq, ov[0].x, ov[0].y, ov[0].z, ov[0].w, ov[1].x, ov[1].y, ov[1].z, ov[1].w, h);
          __builtin_amdgcn_sched_barrier(0);
        }
      ss2[b] = s2;
    }
    if (l == 0) {
      __syncthreads();
#pragma unroll
      for (int b = 0; b < NB; ++b) {
        const float s2 = ss2[b] + xor32(ss2[b]);
        if (h == 0) part_s[wave * 128 + b * 32 + r31] = s2;
      }
      row_exchange(part_s, tot_s, pg1, c1, nt, tid);
      if (nt == 0 && tid < 128) p.rstd()[m0 + tid] = rsqrtf(tot_s[tid] * (1.0f / 1024.0f) + EPS);
    }
  }
}


DI void gemm_p14(const Params& p, int l, int mt, unsigned char* smem, int tid) {
  const int lane = tid & 63, wave = tid >> 6, r31 = lane & 31, h = lane >> 5;
  const int m0 = mt * 128;
  const u16* A = p.xb();
  const u16* Wf = p.WinT() + (size_t)l * NPW * 1024 + ((size_t)112 * 64 * 64 + lane) * 8;
  f32x16 acc[2];
#pragma unroll
  for (int a = 0; a < 2; ++a)
#pragma unroll
    for (int i = 0; i < 16; ++i) acc[a][i] = 0.f;
  const int lrow = tid >> 3, lch = tid & 7;
  const char* Abase = (const char*)(A + (size_t)m0 * 1024);
  const unsigned xoff = (unsigned)((lrow * 1024 + lch * 8) * 2);
  u32x4 xr[4], wq[8];
#define P14_XLOAD(KTI) { _Pragma("unroll") for (int rep = 0; rep < 4; ++rep) xr[rep] = *(const u32x4*)(Abase + (size_t)(rep * 65536 + (KTI) * 128) + xoff); }
#define P14_XSTORE(BUF) { _Pragma("unroll") for (int rep = 0; rep < 4; ++rep) *(u32x4*)((u16*)(smem + (BUF) * 18432) + (lrow + rep * 32) * 72 + lch * 8) = xr[rep]; }
#define P14_WLD(A_, KS_, KTI) (*(const u32x4*)(Wf + (size_t)((A_) * 64 + (KTI) * 4 + (KS_)) * 512))
#define P14_COMPUTE(BUF, KTI) { const u16* Xb = (const u16*)(smem + (BUF) * 18432); \
    _Pragma("unroll") for (int ks = 0; ks < 4; ++ks) { \
      const bf16x8 xf = *(const bf16x8*)(Xb + (wave * 32 + r31) * 72 + ks * 16 + h * 8); \
      _Pragma("unroll") for (int a = 0; a < 2; ++a) { \
        acc[a] = MFMA32(__builtin_bit_cast(bf16x8, wq[a * 4 + ks]), xf, acc[a]); \
        if ((KTI) + 1 < 16) wq[a * 4 + ks] = P14_WLD(a, ks, (KTI) + 1); } \
      __builtin_amdgcn_sched_barrier(0); } }
  __syncthreads();
  P14_XLOAD(0);
#pragma unroll
  for (int a = 0; a < 2; ++a)
#pragma unroll
    for (int ks = 0; ks < 4; ++ks) wq[a * 4 + ks] = P14_WLD(a, ks, 0);
  P14_XSTORE(0);
  P14_XLOAD(1);
  __syncthreads();
  for (int kt = 0; kt < 16; kt += 2) {
    P14_COMPUTE(0, kt);
    P14_XSTORE(1);
    if (kt + 2 < 16) P14_XLOAD(kt + 2);
    __syncthreads();
    P14_COMPUTE(1, kt + 1);
    if (kt + 2 < 16) { P14_XSTORE(0); }
    if (kt + 3 < 16) P14_XLOAD(kt + 3);
    __syncthreads();
  }
  const int tok = m0 + wave * 32 + r31;
  const float rs = p.rstd()[tok];
  u16* dst = p.proj() + (size_t)tok * NP + C_KR;
#pragma unroll
  for (int a = 0; a < 2; ++a)
#pragma unroll
    for (int gp = 0; gp < 2; ++gp)
      store8_pair(dst + a * 32 + 16 * gp, acc[a][8 * gp] * rs, acc[a][8 * gp + 1] * rs, acc[a][8 * gp + 2] * rs, acc[a][8 * gp + 3] * rs,
                  acc[a][8 * gp + 4] * rs, acc[a][8 * gp + 5] * rs, acc[a][8 * gp + 6] * rs, acc[a][8 * gp + 7] * rs, h);
}

DI void compress_job(const Params& p, int l, int kv, int rt, unsigned char* smem, int tid) {
  const int lane = tid & 63, wave = tid >> 6, r31 = lane & 31, h = lane >> 5;
  u16* Hs = (u16*)(smem + 41472);
  const u16* W1 = p.W1T() + (size_t)(l * 2 + kv) * 256 * 2048;
  const u16* W2 = p.W2T() + (size_t)(l * 2 + kv) * 64 * 256;
  const float* pos = (kv ? p.pos_v : p.pos_k) + l * 2048;
  const int segc = kv ? CC_VC : CC_KC;

  const int lrow = tid >> 3, lch = tid & 7;
  int r = rt * 32 + lrow; if (r > 1015) r = 1015;
  const int ab = r / 127, an = r % 127;
  const u16* arow = p.proj() + (size_t)(ab * 2048 + 16 * an) * NP + segc + lch * 8;

  f32x16 acc[2];
#pragma unroll
  for (int a = 0; a < 2; ++a)
#pragma unroll
    for (int i = 0; i < 16; ++i) acc[a][i] = 0.f;

  const u16* Wf = W1 + ((size_t)(wave * 2) * 128 * 64 + lane) * 8;
  u32x4 xr, wq[8];
#define C_XLOAD(KTI) { \
    const u32x4 v_ = *(const u32x4*)(arow + (size_t)(KTI) * NP); \
    const f32x4 p0_ = *(const f32x4*)(pos + (KTI) * 64 + lch * 8); \
    const f32x4 p1_ = *(const f32x4*)(pos + (KTI) * 64 + lch * 8 + 4); \
    xr.x = pk2(bflo(v_.x) + p0_.x, bfhi(v_.x) + p0_.y); xr.y = pk2(bflo(v_.y) + p0_.z, bfhi(v_.y) + p0_.w); \
    xr.z = pk2(bflo(v_.z) + p1_.x, bfhi(v_.z) + p1_.y); xr.w = pk2(bflo(v_.w) + p1_.z, bfhi(v_.w) + p1_.w); }
#define C_XSTORE(BUF) { *(u32x4*)((u16*)(smem + (BUF) * 4608) + lrow * 72 + lch * 8) = xr; }
#define C_WLD(A_, KS_, KTI) (*(const u32x4*)(Wf + (size_t)((A_) * 128 + (KTI) * 4 + (KS_)) * 512))
#define C_COMPUTE(BUF, KTI) { const u16* Xb = (const u16*)(smem + (BUF) * 4608); \
    _Pragma("unroll") for (int ks = 0; ks < 4; ++ks) { \
      const bf16x8 xf = *(const bf16x8*)(Xb + r31 * 72 + ks * 16 + h * 8); \
      _Pragma("unroll") for (int a = 0; a < 2; ++a) { \
        acc[a] = MFMA32(__builtin_bit_cast(bf16x8, wq[a * 4 + ks]), xf, acc[a]); \
        if ((KTI) + 1 < 32) wq[a * 4 + ks] = C_WLD(a, ks, (KTI) + 1); } } }
  __syncthreads();
  C_XLOAD(0);
#pragma unroll
  for (int a = 0; a < 2; ++a)
#pragma unroll
    for (int ks = 0; ks < 4; ++ks) wq[a * 4 + ks] = C_WLD(a, ks, 0);
  C_XSTORE(0);
  C_XLOAD(1);
  __syncthreads();
  for (int kt = 0; kt < 32; kt += 2) {
    C_COMPUTE(0, kt);
    C_XSTORE(1);
    if (kt + 2 < 32) C_XLOAD(kt + 2);
    __syncthreads();
    C_COMPUTE(1, kt + 1);
    if (kt + 2 < 32) { C_XSTORE(0); }
    if (kt + 3 < 32) C_XLOAD(kt + 3);
    __syncthreads();
  }
#pragma unroll
  for (int a = 0; a < 2; ++a)
#pragma unroll
    for (int g = 0; g < 4; ++g)
      store4(Hs + r31 * 264 + wave * 64 + a * 32 + 8 * g + 4 * h, siluf_(acc[a][4 * g]), siluf_(acc[a][4 * g + 1]), siluf_(acc[a][4 * g + 2]), siluf_(acc[a][4 * g + 3]));
  __syncthreads();
  if (wave < 2) {
    f32x16 o;
#pragma unroll
    for (int i = 0; i < 16; ++i) o[i] = 0.f;
#pragma unroll 4
    for (int ks = 0; ks < 16; ++ks) {
      const bf16x8 wf = *(const bf16x8*)(W2 + (size_t)(wave * 32 + r31) * 256 + ks * 16 + h * 8);
      const bf16x8 hf = *(const bf16x8*)(Hs + r31 * 264 + ks * 16 + h * 8);
      o = MFMA32(wf, hf, o);
    }
    const int rr = rt * 32 + r31;
    if (rr < 1016) {
      const int b = rr / 127, n = rr % 127;
      u16* dst = (kv ? p.vc() : p.kc()) + (size_t)(b * 128 + n) * 64 + wave * 32;
#pragma unroll
      for (int g = 0; g < 4; ++g) store4(dst + 8 * g + 4 * h, o[4 * g], o[4 * g + 1], o[4 * g + 2], o[4 * g + 3]);
    }
  }
}

enum { M_A = 0, M_B = 1, M_WIN = 2, M_SLC = 3, M_D = 4 };
constexpr float LOG2E = 1.4426950408889634f;
constexpr int L_TAB = 59392;
constexpr int L_DFLAG = 70800;

DI float ex2(float x) { return __builtin_amdgcn_exp2f(x); }
DI float lg2(float x) { return __builtin_amdgcn_logf(x); }

DI int next_slc(unsigned tm, int kt) { const unsigned mk = tm & ((1u << kt) - 1u); return mk ? 31 - __builtin_clz(mk) : -1; }

DI float dil_log2w(int dist) {
  const int c1 = (dist <= 128) ? 1 : 0;
  const int c2 = (((dist & 3) == 0) && dist <= 512) ? 1 : 0;
  const int c3 = ((dist & 15) == 0) ? 1 : 0;
  const int w = c1 + c2 + c3;
  const float lw = (w == 3) ? 1.5849625007211562f : ((w == 2) ? 1.0f : 0.f);
  return (dist >= 0 && w > 0) ? lw : NEGM;
}

template <int MODE, bool MASKED>
DI void softmax_tile(f32x16 (&s)[2], int d0, float sc2, bool selbit, const float* tb, float& m, float& lsum, f32x16& o0, f32x16& o1) {
  if (!MASKED && MODE != M_A) {
    const bool live = (MODE != M_SLC) || selbit;
    float mr = NEGM;
#pragma unroll
    for (int ks = 0; ks < 2; ++ks)
#pragma unroll
      for (int i = 0; i < 16; ++i) mr = fmaxf(mr, s[ks][i]);
    mr = fmaxf(mr, xor32(mr));
    const float mx = live ? fmaxf(m, mr * sc2) : m;
    const float alpha = ex2(m - mx);
    m = mx;
    const float nmx = live ? -mx : NEGM;
    float psum = 0.f;
#pragma unroll
    for (int ks = 0; ks < 2; ++ks)
#pragma unroll
      for (int i = 0; i < 16; ++i) {
        const float pe = ex2(fmaf(s[ks][i], sc2, nmx));
        s[ks][i] = pe;
        psum += pe;
      }
    lsum = lsum * alpha + psum;
#pragma unroll
    for (int i = 0; i < 16; ++i) { o0[i] *= alpha; o1[i] *= alpha; }
    return;
  }
  float mx = m;
  const float lb = (MODE == M_SLC && !selbit) ? NEGM : 0.f;
#pragma unroll
  for (int ks = 0; ks < 2; ++ks)
#pragma unroll
    for (int i = 0; i < 16; ++i) {
      const int c = ks * 32 + 8 * (i >> 2) + (i & 3);
      float sv;
      if (MODE == M_A) sv = s[ks][i] * sc2 + tb[63 - c];
      else if (!MASKED) sv = (MODE == M_SLC) ? (s[ks][i] * sc2 + lb) : (s[ks][i] * sc2);
      else {
        const int dist = d0 - c;
        bool ok;
        if (MODE == M_WIN) ok = ((unsigned)dist <= 511u);
        else if (MODE == M_SLC) ok = selbit && (dist >= 0);
        else ok = (dist >= 0);
        sv = ok ? (s[ks][i] * sc2) : NEGM;
      }
      s[ks][i] = sv;
      mx = fmaxf(mx, sv);
    }
  mx = fmaxf(mx, xor32(mx));
  const float alpha = ex2(m - mx);
  m = mx;
  float psum = 0.f;
#pragma unroll
  for (int ks = 0; ks < 2; ++ks)
#pragma unroll
    for (int i = 0; i < 16; ++i) {
      const float pe = ex2(s[ks][i] - mx);
      s[ks][i] = pe;
      psum += pe;
    }
  lsum = lsum * alpha + psum;
#pragma unroll
  for (int i = 0; i < 16; ++i) { o0[i] *= alpha; o1[i] *= alpha; }
}

template <bool MASKED>
DI void stick_tile(f32x16 (&s)[2], int d0, float sc2, int h, float& R) {
  f32x16 lk[2];
  float G[2][4], Gp[2][4];
#pragma unroll
  for (int ks = 0; ks < 2; ++ks)
#pragma unroll
    for (int i = 0; i < 16; ++i) {
      const float z = s[ks][i] * sc2;
      const float e = ex2(-fabsf(z));
      const float lp = lg2(1.0f + e);
      float v = fminf(-z, 0.f) - lp;
      if (MASKED) { const int dist = d0 - (ks * 32 + 8 * (i >> 2) + (i & 3)); v = (dist > 0) ? v : 0.f; }
      s[ks][i] = z;
      lk[ks][i] = v;
    }
#pragma unroll
  for (int ks = 0; ks < 2; ++ks)
#pragma unroll
    for (int g = 0; g < 4; ++g) {
      G[ks][g] = (lk[ks][4 * g] + lk[ks][4 * g + 1]) + (lk[ks][4 * g + 2] + lk[ks][4 * g + 3]);
      Gp[ks][g] = xor32(G[ks][g]);
    }
  float accs = 0.f;
#pragma unroll
  for (int ks = 1; ks >= 0; --ks)
#pragma unroll
    for (int g = 3; g >= 0; --g) {
      const float base = R + accs + (h == 0 ? Gp[ks][g] : 0.f);
      float run = 0.f;
#pragma unroll
      for (int r = 3; r >= 0; --r) {
        const int i = 4 * g + r;
        float a = ex2(s[ks][i] + lk[ks][i] + (base + run));
        if (MASKED) { const int dist = d0 - (ks * 32 + 8 * g + r); a = (dist > 0) ? a : 0.f; }
        run += lk[ks][i];
        s[ks][i] = a;
      }
      accs += G[ks][g] + Gp[ks][g];
    }
  R += accs;
}

#define ATT_ISSUE(KT) { \
    _Pragma("unroll") for (int rep = 0; rep < NKR; ++rep) { const int c = tid + rep * 256; const int key = c / (KC * 2), ch = c % (KC * 2); \
      kr[rep] = *(const u32x4*)(Kg + (size_t)((KT) * 64 + key) * ldk + ch * 8); } \
    vr0 = *(const u32x4*)(Vg + (size_t)((KT) * 64 + 2 * vkp) * ldv + vdc * 8); \
    vr1 = *(const u32x4*)(Vg + (size_t)((KT) * 64 + 2 * vkp + 1) * ldv + vdc * 8); }
#define ATT_COMMIT(BUF) { u16* Ksw = (u16*)(smem + (BUF) * 36864); unsigned* vd = (unsigned*)(smem + (BUF) * 36864 + 13312) + (vdc * 8) * 34 + vkp; \
    _Pragma("unroll") for (int rep = 0; rep < NKR; ++rep) { const int c = tid + rep * 256; const int key = c / (KC * 2), ch = c % (KC * 2); \
      *(u32x4*)(Ksw + key * KST + ch * 8) = kr[rep]; } \
    vd[0 * 34] = (vr0.x & 0xffffu) | (vr1.x << 16); vd[1 * 34] = (vr0.x >> 16) | (vr1.x & 0xffff0000u); \
    vd[2 * 34] = (vr0.y & 0xffffu) | (vr1.y << 16); vd[3 * 34] = (vr0.y >> 16) | (vr1.y & 0xffff0000u); \
    vd[4 * 34] = (vr0.z & 0xffffu) | (vr1.z << 16); vd[5 * 34] = (vr0.z >> 16) | (vr1.z & 0xffff0000u); \
    vd[6 * 34] = (vr0.w & 0xffffu) | (vr1.w << 16); vd[7 * 34] = (vr0.w >> 16) | (vr1.w & 0xffff0000u); }
#define ATT_NEXT(KT) ((MODE == M_SLC) ? next_slc(tm, (KT)) : ((((KT) - 1) >= kt_lo) ? ((KT) - 1) : -1))

template <int MODE, int KC>
DI void attn_loop(const u16* __restrict__ Kg, int ldk, const u16* __restrict__ Vg, int ldv, int kt_hi, int kt_lo,
                  unsigned tilemask, const bf16x8 (&qf)[KC], int qpos, float scale, unsigned selbits, float& m,
                  float& lsum, float& R, f32x16& o0, f32x16& o1, unsigned char* smem, int tid) {
  constexpr int KST = KC * 16 + 8;
  constexpr int NKR = KC / 2;
  const int lane = tid & 63, r31 = lane & 31, h = lane >> 5, wave = tid >> 6;
  const float sc2 = scale * LOG2E;
  const int q0 = __builtin_amdgcn_readfirstlane(qpos);
  unsigned tm = tilemask;
  if (MODE == M_SLC) { if (kt_hi < 31) tm &= ((2u << kt_hi) - 1u); }
  int kt = (MODE == M_SLC) ? (tm ? 31 - __builtin_clz(tm) : -1) : kt_hi;
  if (kt < kt_lo) return;
  const int vkp = tid & 31, vdc = tid >> 5;
  const float* tab = (const float*)(smem + L_TAB);
  volatile int* dflag = (volatile int*)(smem + L_DFLAG);
  u32x4 kr[NKR], vr0, vr1;
  ATT_ISSUE(kt);
  __syncthreads();
  ATT_COMMIT(0);
  int nxt = ATT_NEXT(kt);
  if (nxt >= 0) ATT_ISSUE(nxt);
  __syncthreads();
  int buf = 0, it = 0;
  for (;;) {
    const u16* Ks = (const u16*)(smem + buf * 36864);
    const u16* Vt = (const u16*)(smem + buf * 36864 + 13312);
    const int k0 = kt * 64;
    int cls;
    if (MODE == M_A) cls = 2;
    else if (MODE == M_B || MODE == M_SLC) cls = (k0 > q0 + 31) ? 0 : ((k0 + 63 <= q0) ? 1 : 2);
    else if (MODE == M_D) cls = (k0 >= q0 + 31) ? 0 : ((k0 + 63 < q0) ? 1 : 2);
    else cls = (k0 > q0 + 31 || q0 - (k0 + 63) > 511) ? 0 : ((k0 + 63 <= q0 && q0 + 31 - k0 <= 511) ? 1 : 2);
    if (cls != 0) {
      f32x16 s[2];
#pragma unroll
      for (int i = 0; i < 16; ++i) { s[0][i] = 0.f; s[1][i] = 0.f; }
#pragma unroll
      for (int kc = 0; kc < KC; ++kc) {
        const bf16x8 a0 = *(const bf16x8*)(Ks + r31 * KST + kc * 16 + h * 8);
        const bf16x8 a1 = *(const bf16x8*)(Ks + (32 + r31) * KST + kc * 16 + h * 8);
        s[0] = MFMA32(a0, qf[kc], s[0]);
        s[1] = MFMA32(a1, qf[kc], s[1]);
      }
      const int d0 = qpos - k0 - 4 * h;
      if (MODE == M_D) {
        if (cls == 1) stick_tile<false>(s, d0, sc2, h, R);
        else stick_tile<true>(s, d0, sc2, h, R);
      } else {
        const bool selbit = (selbits >> kt) & 1u;
        const float* tb = tab + (d0 + 65);
        if (cls == 1) softmax_tile<MODE, false>(s, d0, sc2, selbit, tb, m, lsum, o0, o1);
        else softmax_tile<MODE, true>(s, d0, sc2, selbit, tb, m, lsum, o0, o1);
      }
#pragma unroll
      for (int ks = 0; ks < 2; ++ks)
#pragma unroll
        for (int s2 = 0; s2 < 2; ++s2) {
          const bf16x8 pb = pack8(s[ks][8 * s2 + 0], s[ks][8 * s2 + 1], s[ks][8 * s2 + 2], s[ks][8 * s2 + 3], s[ks][8 * s2 + 4], s[ks][8 * s2 + 5], s[ks][8 * s2 + 6], s[ks][8 * s2 + 7]);
          const int koff = ks * 32 + 16 * s2 + 4 * h;
          const bf16x8 va = ld2x8(Vt + r31 * 68 + koff, Vt + r31 * 68 + koff + 8);
          const bf16x8 vb = ld2x8(Vt + (32 + r31) * 68 + koff, Vt + (32 + r31) * 68 + koff + 8);
          o0 = MFMA32(va, pb, o0);
          o1 = MFMA32(vb, pb, o1);
        }
    }
    if (nxt < 0) break;
    if (MODE == M_D) {
      const bool done = (__ballot(R < -200.0f) == ~0ull);
      if (lane == 0) dflag[(it & 1) * 4 + wave] = done ? 1 : 0;
    }
    ATT_COMMIT(buf ^ 1);
    kt = nxt;
    nxt = ATT_NEXT(kt);
    if (nxt >= 0) ATT_ISSUE(nxt);
    __syncthreads();
    if (MODE == M_D) {
      const int a = (it & 1) * 4;
      if (dflag[a] & dflag[a + 1] & dflag[a + 2] & dflag[a + 3]) break;
    }
    buf ^= 1;
    ++it;
  }
}

DI void store_gated(const f32x16& o0, const f32x16& o1, const u16* __restrict__ gate, u16* __restrict__ dst, int h) {
#pragma unroll
  for (int ds = 0; ds < 2; ++ds)
#pragma unroll
    for (int gq = 0; gq < 2; ++gq) {
      const f32x16& o = ds ? o1 : o0;
      float v[8];
      u32x2 gpair[2];
      load8_pair(gate + ds * 32 + 16 * gq, h, gpair[0], gpair[1]);
#pragma unroll
      for (int u = 0; u < 2; ++u) {
        const int g = 2 * gq + u;
        const u32x2 gv = gpair[u];
        v[4 * u + 0] = o[4 * g] * siluf_(bflo(gv.x)); v[4 * u + 1] = o[4 * g + 1] * siluf_(bfhi(gv.x));
        v[4 * u + 2] = o[4 * g + 2] * siluf_(bflo(gv.y)); v[4 * u + 3] = o[4 * g + 3] * siluf_(bfhi(gv.y));
      }
      store8_pair(dst + ds * 32 + 16 * gq, v[0], v[1], v[2], v[3], v[4], v[5], v[6], v[7], h);
    }
}

DI void zero16(f32x16& v) {
#pragma unroll
  for (int i = 0; i < 16; ++i) v[i] = 0.f;
}

template <int MODE>
DI void attn_job_abd(const Params& p, int b, int hd, int qb, unsigned char* smem, int tid) {
  constexpr int KC = (MODE == M_B) ? 6 : 4;
  const int lane = tid & 63, wave = tid >> 6, r31 = lane & 31, h = lane >> 5;
  const int qpos = qb * 128 + wave * 32 + r31;
  const size_t tok = (size_t)b * SEQ + qpos;
  const size_t tb0 = (size_t)b * SEQ;
  const u16 *Qp, *Kg, *Vg, *gate; int ldk, ldv, ocol; float scale;
  if (MODE == M_A) {
    Qp = p.proj() + tok * NP + CA_Q + hd * 64; Kg = p.proj() + tb0 * NP + CA_K + hd * 64; Vg = p.proj() + tb0 * NP + CA_V + hd * 64;
    ldk = NP; ldv = NP; gate = p.proj() + tok * NP + CA_G + hd * 64; ocol = 0; scale = 0.125f;
  } else if (MODE == M_B) {
    Qp = p.qB() + tok * 384 + hd * 96; Kg = p.kB() + tb0 * 384 + hd * 96; Vg = p.vB() + tb0 * 256 + hd * 64;
    ldk = 384; ldv = 256; gate = p.proj() + tok * NP + CB_G + hd * 64; ocol = 256; scale = 0.10206207261596577f;
  } else {
    Qp = p.proj() + tok * NP + CD_Q + hd * 64; Kg = p.proj() + tb0 * NP + CD_K + hd * 64; Vg = p.proj() + tb0 * NP + CD_V + hd * 64;
    ldk = NP; ldv = NP; gate = p.proj() + tok * NP + CD_G + hd * 64; ocol = 768; scale = 0.125f;
  }
  bf16x8 qf[KC];
#pragma unroll
  for (int kc = 0; kc < KC; ++kc) qf[kc] = *(const bf16x8*)(Qp + kc * 16 + h * 8);
  f32x16 o0, o1; zero16(o0); zero16(o1);
  float m = MINIT, lsum = 0.f, R = 0.f;
  if (MODE == M_A) {
    __syncthreads();
    float* tab = (float*)(smem + L_TAB);
    for (int i = tid; i < 2176; i += 256) tab[i] = dil_log2w(i - 128);
  }
  attn_loop<MODE, KC>(Kg, ldk, Vg, ldv, 2 * qb + 1, 0, 0xffffffffu, qf, qpos, scale, 0u, m, lsum, R, o0, o1, smem, tid);
  if (MODE != M_D) {
    const float lt = lsum + xor32(lsum);
    const float inv = 1.0f / lt;
#pragma unroll
    for (int i = 0; i < 16; ++i) { o0[i] *= inv; o1[i] *= inv; }
  }
  store_gated(o0, o1, gate, p.mixed() + tok * 1024 + ocol + hd * 64, h);
}

DI void attn_job_c(const Params& p, int b, int tb, unsigned char* smem, int tid) {
  const int lane = tid & 63, wave = tid >> 6, r31 = lane & 31, h = lane >> 5;
  const int t0 = tb * 32;
  const int qpos = t0 + r31;
  const size_t tok = (size_t)b * SEQ + qpos;
  const size_t tb0 = (size_t)b * SEQ;
  const u16* prow = p.proj() + tok * NP;
  bf16x8 qf[4];
#pragma unroll
  for (int kc = 0; kc < 4; ++kc) qf[kc] = *(const bf16x8*)(prow + CC_Q + wave * 64 + kc * 16 + h * 8);
  const float g0 = sigmoidf_(bf2f(prow[C_GL + wave * 3 + 0]));
  const float g1 = sigmoidf_(bf2f(prow[C_GL + wave * 3 + 1]));
  const float g2 = sigmoidf_(bf2f(prow[C_GL + wave * 3 + 2]));
  f32x16 acc0, acc1;

  u16* Kc = (u16*)smem;
  u16* Vct = (u16*)(smem + 18432);
  float* impw = (float*)(smem + L_IMPW);
  float* p3w = (float*)(smem + L_P3W);
  float* impf = (float*)smem;
  unsigned* selm = (unsigned*)(smem + L_SELM);
  unsigned* selany = (unsigned*)(smem + L_SELANY);

  __syncthreads();
  {
    const u16* kcg = p.kc() + (size_t)b * 128 * 64;
    const u16* vcg = p.vc() + (size_t)b * 128 * 64;
#pragma unroll
    for (int rep = 0; rep < 4; ++rep) {
      const int c = tid + rep * 256;
      const int key = c >> 3, ch = c & 7;
      *(u32x4*)(Kc + key * 72 + ch * 8) = *(const u32x4*)(kcg + key * 64 + ch * 8);
    }
#pragma unroll
    for (int rep = 0; rep < 4; ++rep) {
      const int c = tid + rep * 256;
      const int key = c & 127, dc = c >> 7;
      const u32x4 v = *(const u32x4*)(vcg + key * 64 + dc * 8);
      u16* d = Vct + (dc * 8) * 132 + key;
      d[0 * 132] = (u16)(v.x & 0xffffu); d[1 * 132] = (u16)(v.x >> 16);
      d[2 * 132] = (u16)(v.y & 0xffffu); d[3 * 132] = (u16)(v.y >> 16);
      d[4 * 132] = (u16)(v.z & 0xffffu); d[5 * 132] = (u16)(v.z >> 16);
      d[6 * 132] = (u16)(v.w & 0xffffu); d[7 * 132] = (u16)(v.w >> 16);
    }
    if (tid < 32) selm[tid] = 0u;
    if (tid == 32) *selany = 0u;
  }
  __syncthreads();
  {
    f32x16 s[4];
#pragma unroll
    for (int q = 0; q < 4; ++q) zero16(s[q]);
#pragma unroll
    for (int q = 0; q < 4; ++q)
#pragma unroll
      for (int kc = 0; kc < 4; ++kc) {
        const bf16x8 a = *(const bf16x8*)(Kc + (q * 32 + r31) * 72 + kc * 16 + h * 8);
        s[q] = MFMA32(a, qf[kc], s[q]);
      }
    float mx = NEGM;
#pragma unroll
    for (int q = 0; q < 4; ++q)
#pragma unroll
      for (int i = 0; i < 16; ++i) {
        const int n = q * 32 + 8 * (i >> 2) + 4 * h + (i & 3);
        const bool ok = (16 * n + 31 <= qpos);
        const float sv = ok ? s[q][i] * 0.125f : NEGM;
        s[q][i] = sv;
        mx = fmaxf(mx, sv);
      }
    mx = fmaxf(mx, xor32(mx));
    float den = 0.f;
#pragma unroll
    for (int q = 0; q < 4; ++q)
#pragma unroll
      for (int i = 0; i < 16; ++i) {
        const float e = (s[q][i] == NEGM) ? 0.f : __expf(s[q][i] - mx);
        s[q][i] = e;
        den += e;
      }
    den += xor32(den);
    const float inv = 1.0f / fmaxf(den, 1e-30f);
#pragma unroll
    for (int q = 0; q < 4; ++q)
#pragma unroll
      for (int i = 0; i < 16; ++i) s[q][i] *= inv;
#pragma unroll
    for (int q = 0; q < 4; ++q)
#pragma unroll
      for (int g = 0; g < 4; ++g) {
        const int j0 = 8 * q + 2 * g + h;
        impw[(wave * 32 + r31) * 33 + j0] = (s[q][4 * g] + s[q][4 * g + 1]) + (s[q][4 * g + 2] + s[q][4 * g + 3]);
        p3w[(wave * 32 + r31) * 33 + j0] = s[q][4 * g + 3];
      }
    f32x16 o0, o1; zero16(o0); zero16(o1);
#pragma unroll
    for (int q = 0; q < 4; ++q)
#pragma unroll
      for (int s2 = 0; s2 < 2; ++s2) {
        const bf16x8 pb = pack8(s[q][8 * s2 + 0], s[q][8 * s2 + 1], s[q][8 * s2 + 2], s[q][8 * s2 + 3], s[q][8 * s2 + 4], s[q][8 * s2 + 5], s[q][8 * s2 + 6], s[q][8 * s2 + 7]);
        const int koff = q * 32 + 16 * s2 + 4 * h;
        const bf16x8 va = ld2x8(Vct + r31 * 132 + koff, Vct + r31 * 132 + koff + 8);
        const bf16x8 vb = ld2x8(Vct + (32 + r31) * 132 + koff, Vct + (32 + r31) * 132 + koff + 8);
        o0 = MFMA32(va, pb, o0);
        o1 = MFMA32(vb, pb, o1);
        __builtin_amdgcn_sched_barrier(0);
      }
#pragma unroll
    for (int i = 0; i < 16; ++i) { acc0[i] = g0 * o0[i]; acc1[i] = g0 * o1[i]; }
  }
  __syncthreads();
  {
    const int tl = tid >> 3, jb = (tid & 7) * 4;
    const int bt = (t0 + tl) >> 6;
#pragma unroll
    for (int c = 0; c < 4; ++c) {
      const int j = jb + c;
      float v = 0.f;
#pragma unroll
      for (int w = 0; w < 4; ++w) {
        v += impw[(w * 32 + tl) * 33 + j];
        if (j > 0) v += p3w[(w * 32 + tl) * 33 + j - 1];
      }
      const bool forced = (j == 0) || (j == bt) || (j == bt - 1);
      v = forced ? 1e9f : ((j > bt) ? -1e9f : v);
      impf[tl * 33 + j] = v;
    }
  }
  __syncthreads();
  {
    const int tl = tid >> 3, jb = (tid & 7) * 4;
    const int bt = (t0 + tl) >> 6;
    unsigned bits = 0u;
#pragma unroll
    for (int c = 0; c < 4; ++c) {
      const int j = jb + c;
      const float v = impf[tl * 33 + j];
      int rank = 0;
      for (int jj = 0; jj < 32; ++jj) {
        const float vv = impf[tl * 33 + jj];
        rank += ((vv > v) || (vv == v && jj < j)) ? 1 : 0;
      }
      if (rank < 16 && j <= bt) bits |= (1u << j);
    }
    atomicOr(&selm[tl], bits);
    atomicOr(selany, bits);
  }
  __syncthreads();
  const unsigned mysel = selm[r31];
  const unsigned anysel = *selany;
  const int bt0 = t0 >> 6;
  {
    f32x16 o0, o1; zero16(o0); zero16(o1);
    float m = MINIT, lsum = 0.f, R = 0.f;
    attn_loop<M_SLC, 4>(p.proj() + tb0 * NP + CC_KS, NP, p.proj() + tb0 * NP + CC_VS, NP, bt0, 0, anysel, qf, qpos, 0.125f, mysel, m, lsum, R, o0, o1, smem, tid);
    const float lt = lsum + xor32(lsum);
    const float sc = g1 / lt;
#pragma unroll
    for (int i = 0; i < 16; ++i) { acc0[i] += sc * o0[i]; acc1[i] += sc * o1[i]; }
  }
  {
    f32x16 o0, o1; zero16(o0); zero16(o1);
    float m = MINIT, lsum = 0.f, R = 0.f;
    int lo = (t0 - 511) >> 6; if (lo < 0) lo = 0;
    attn_loop<M_WIN, 4>(p.proj() + tb0 * NP + CC_KW, NP, p.proj() + tb0 * NP + CC_VW, NP, bt0, lo, 0xffffffffu, qf, qpos, 0.125f, 0u, m, lsum, R, o0, o1, smem, tid);
    const float lt = lsum + xor32(lsum);
    const float sc = g2 / lt;
#pragma unroll
    for (int i = 0; i < 16; ++i) { acc0[i] += sc * o0[i]; acc1[i] += sc * o1[i]; }
  }
  store_gated(acc0, acc1, prow + CC_G + wave * 64, p.mixed() + tok * 1024 + 512 + wave * 64, h);
}

DI void phase_inproj(const Params& p, int l, int bid, int nb, unsigned char* smem, int tid) {
  {
    u32x4 xr[4], wq[8];
    bool pre = false;
    for (int tile = bid; tile < 1536; tile += nb) {
      int nmt = -1, nnt = 0;
      const int nx = tile + nb;
      if (nx < 1536) { nmt = nx % 128; nnt = nx / 128; }
      else if (nb == 512 && bid < 256) { nmt = bid % 128; nnt = 12 + bid / 128; }
      gemm_big<0, 4>(p, l, tile % 128, tile / 128, smem, launder(tid), xr, wq, pre, nmt, nnt);
      pre = (nmt >= 0);
    }
    for (int u = bid; u < 256; u += nb) { gemm_big<0, 4>(p, l, u % 128, 12 + u / 128, smem, launder(tid), xr, wq, pre && (nb == 512), -1, 0); pre = false; }
  }
  for (int u = (bid < 256 ? bid + ((256 - bid + nb - 1) / nb) * nb : bid); u < 384; u += nb) gemm_p14(p, l, u - 256, smem, launder(tid));
}

DI void prep_job(const Params& p, int l, int job, unsigned char* smem, int tid) {
  if (job < 64) compress_job(p, l, job >> 5, job & 31, smem, tid);
  else if (job < 448) { const int j = job - 64; gemm128<1>(p, l, j % 128, j / 128, smem, tid); }
  else if (job < 960) { const int j = job - 448; gemm128<2>(p, l, j % 128, j / 128, smem, tid); }
  else {
    const int j = job - 960;
    for (int it = tid; it < 1024; it += 256) {
      const int idx = j * 1024 + it;
      const int tok = idx >> 2, i4 = (idx & 3) * 4;
      const u32x2 a1 = *(const u32x2*)(p.proj() + (size_t)tok * NP + C_KR + i4);
      const u32x2 a2 = *(const u32x2*)(p.proj() + (size_t)tok * NP + C_KR + 16 + i4);
      const f32x4 cs = *(const f32x4*)(p.c32() + tok * 16 + i4);
      const f32x4 sn = *(const f32x4*)(p.s32() + tok * 16 + i4);
      const float x10 = bflo(a1.x), x11 = bfhi(a1.x), x12 = bflo(a1.y), x13 = bfhi(a1.y);
      const float x20 = bflo(a2.x), x21 = bfhi(a2.x), x22 = bflo(a2.y), x23 = bfhi(a2.y);
#pragma unroll
      for (int hd = 0; hd < 4; ++hd) {
        u16* kb = p.kB() + (size_t)tok * 384 + hd * 96 + 64 + i4;
        store4(kb, x10 * cs.x - x20 * sn.x, x11 * cs.y - x21 * sn.y, x12 * cs.z - x22 * sn.z, x13 * cs.w - x23 * sn.w);
        store4(kb + 16, x10 * sn.x + x20 * cs.x, x11 * sn.y + x21 * cs.y, x12 * sn.z + x22 * cs.z, x13 * sn.w + x23 * cs.w);
      }
    }
  }
}

DI void phase_attn(const Params& p, int lc, unsigned char* smem, int tid_in, const XcdBarrier& xb) {
  const int l = lc & 1;
  int* jobp = (int*)(smem + L_JOB);
  unsigned* xsub = (unsigned*)(p.ctr() + 16 + lc * 16);
  unsigned* ready = (unsigned*)(p.ctr() + 48 + lc);
  const int NCONV = (lc == 0) ? 128 : 0;
  bool left_prep = false, prep_ok = false;
  for (;;) {
    int tid = tid_in;
    asm volatile("" : "+v"(tid));
    __syncthreads();
    if (tid == 0) *jobp = atomicAdd(p.ctr() + lc, 1);
    __syncthreads();
    const int job = *jobp;
    if (job >= 1024 && !left_prep) {
      asm volatile("s_waitcnt vmcnt(0)" ::: "memory");
      __syncthreads();
      if (tid == 0) {
        const unsigned nloc = xb.st[0];
        const unsigned old = xb_add(&xsub[xb.st[2]], 1u);
        if (old + 1u == nloc) {
          __builtin_amdgcn_fence(__ATOMIC_RELEASE, "agent");
          asm volatile("s_waitcnt vmcnt(0)" ::: "memory");
          (void)xb_add(ready, 1u);
        }
      }
      left_prep = true;
    }
    if (job >= 3072 + NCONV) break;
    if (job < 1024) {
      prep_job(p, l, job, smem, tid);
    } else if (job < 1024 + NCONV) {
      conv_weights(p, 1, (job - 1024) * 256 + tid, NCONV * 256);
    } else if (job < 1536 + NCONV) {
      const int j = job - 1024 - NCONV;
      const int level = 15 - (j >> 5), r = j & 31;
      attn_job_abd<M_D>(p, r >> 2, r & 3, level, smem, tid);
    } else {
      const int j = job - 1536 - NCONV;
      int level, r;
      if (j < 192) { level = 15 - j / 32; r = j % 32; }
      else if (j < 1152) { const int jj = j - 192; const int sl = 6 + jj / 96; r = jj % 96; level = (r < 32) ? (15 - sl) : (21 - sl); }
      else { const int jj = j - 1152; const int sl = 16 + jj / 64; r = 32 + jj % 64; level = 21 - sl; }
      if (r >= 64) attn_job_abd<M_A>(p, (r - 64) >> 2, (r - 64) & 3, level, smem, tid);
      else {
        if (!prep_ok) {
          if (tid == 0) {
            const unsigned nx = xb.st[1];
            unsigned sp = 0;
            while (xb_ld(ready) < nx) { __builtin_amdgcn_s_sleep(2); if (++sp > (1u << 22)) break; }
            __builtin_amdgcn_fence(__ATOMIC_ACQUIRE, "agent");
            asm volatile("s_waitcnt vmcnt(0)" ::: "memory");
          }
          __syncthreads();
          prep_ok = true;
        }
        if (r < 32) attn_job_c(p, r >> 2, 4 * level + (r & 3), smem, tid);
        else attn_job_abd<M_B>(p, (r - 32) >> 2, (r - 32) & 3, level, smem, tid);
      }
    }
  }
}

DI void phase_outproj(const Params& p, int l, int bid, int nb, unsigned char* smem, int tid) {
  for (int tile = bid; tile < 128 * 4; tile += nb) { u32x4 xr[4], wq[8]; gemm_big<3, 4>(p, l, tile % 128, tile / 128, smem, launder(tid), xr, wq, false, -1, 0); }
}

DI void phase_post(const Params& p, int l, int bid, int nb, int tid) {
  const int wave = tid >> 6, lane = tid & 63;
  const float* gp = p.g_post + l * 1024;
  for (int row = bid * 4 + wave; row < T_TOK; row += nb * 4) {
    const u16* y = p.proj() + (size_t)row * 1024;
    f32x4 yv[4];
    float ss = 0.f;
#pragma unroll
    for (int c = 0; c < 4; ++c) {
      const u32x2 yb = *(const u32x2*)(y + c * 256 + lane * 4);
      yv[c].x = bflo(yb.x); yv[c].y = bfhi(yb.x); yv[c].z = bflo(yb.y); yv[c].w = bfhi(yb.y);
      ss += yv[c].x * yv[c].x + yv[c].y * yv[c].y + yv[c].z * yv[c].z + yv[c].w * yv[c].w;
    }
#pragma unroll
    for (int off = 32; off >= 1; off >>= 1) ss += __shfl_xor(ss, off, 64);
    const float rs = rsqrtf(ss * (1.0f / 1024.0f) + EPS);
    float ss2 = 0.f;
#pragma unroll
    for (int c = 0; c < 4; ++c) {
      f32x4 xv;
      if (l == 0) xv = *(const f32x4*)(p.x + (size_t)row * 1024 + c * 256 + lane * 4);
      else {
        const u32x2 xb2 = *(const u32x2*)(p.xb() + (size_t)row * 1024 + c * 256 + lane * 4);
        xv.x = bflo(xb2.x); xv.y = bfhi(xb2.x); xv.z = bflo(xb2.y); xv.w = bfhi(xb2.y);
      }
      const f32x4 gv = *(const f32x4*)(gp + c * 256 + lane * 4);
      f32x4 o;
      o.x = xv.x + yv[c].x * rs * gv.x; o.y = xv.y + yv[c].y * rs * gv.y;
      o.z = xv.z + yv[c].z * rs * gv.z; o.w = xv.w + yv[c].w * rs * gv.w;
      if (l == 1) *(f32x4*)(p.out + (size_t)row * 1024 + c * 256 + lane * 4) = o;
      if (l == 0) {
        ss2 += o.x * o.x + o.y * o.y + o.z * o.z + o.w * o.w;
        u32x2 ob; ob.x = pk2(o.x, o.y); ob.y = pk2(o.z, o.w);
        *(u32x2*)(p.xb() + (size_t)row * 1024 + c * 256 + lane * 4) = ob;
      }
    }
    if (l == 0) {
#pragma unroll
      for (int off = 32; off >= 1; off >>= 1) ss2 += __shfl_xor(ss2, off, 64);
      if (lane == 0) p.rstd()[row] = rsqrtf(ss2 * (1.0f / 1024.0f) + EPS);
    }
  }
}

__global__ void __launch_bounds__(256, 2) fwd_megakernel(Params p) {
  __shared__ __attribute__((aligned(16))) unsigned char smem[SMEM_BYTES];
  __shared__ __attribute__((aligned(16))) unsigned xb_words[4];
  cg::grid_group grid = cg::this_grid();
  const int tid = threadIdx.x, bid = blockIdx.x, nb = gridDim.x;
  if (tid == 0) { xb_words[0] = 0u; xb_words[1] = 0u; xb_words[2] = 0u; xb_words[3] = 0u; }
  __syncthreads();
  const XcdBarrier xb = xcd_barrier_post(p.bar(), (volatile LAS unsigned*)xb_words);
  if (p.use_cg) grid.sync();
  phase_init(relaunder(p), bid, nb, launder(tid));
  xcd_barrier_(xb, p.bar());
#pragma unroll 1
  for (int l = 0; l < 2; ++l) {
    phase_inproj(relaunder(p), l, bid, nb, smem, launder(tid));
    xcd_barrier_(xb, p.bar());
    phase_attn(relaunder(p), l, smem, launder(tid), xb);
    xcd_barrier_(xb, p.bar());
    phase_outproj(relaunder(p), l, bid, nb, smem, launder(tid));
    if (nb < 512) {
      xcd_barrier_(xb, p.bar());
      phase_post(relaunder(p), l, bid, nb, launder(tid));
    }
    if (l == 0) xcd_barrier_(xb, p.bar());
  }
}

extern "C" void kernel_launch(void* const* d_in, const int* in_sizes, int n_in, void* d_out, int out_size, void* d_ws,
                              size_t ws_size, hipStream_t stream) {
  Params p{};
  p.x = (const float*)d_in[0];
  p.positions = (const int*)d_in[1];
  p.w_in = (const float*)d_in[2];
  p.w_out = (const float*)d_in[3];
  p.g_pre = (const float*)d_in[4];
  p.g_post = (const float*)d_in[5];
  p.g_q = (const float*)d_in[6];
  p.g_kv = (const float*)d_in[7];
  p.w_uq = (const float*)d_in[8];
  p.w_ukv = (const float*)d_in[9];
  p.pos_k = (const float*)d_in[10];
  p.pos_v = (const float*)d_in[11];
  p.kw1 = (const float*)d_in[12];
  p.kw2 = (const float*)d_in[13];
  p.vw1 = (const float*)d_in[14];
  p.vw2 = (const float*)d_in[15];
  p.out = (float*)d_out;
  p.ws = (char*)d_ws;
  p.use_cg = 0;
  const size_t off = WS_TOTAL;
  if (off > ws_size) { fprintf(stderr, "workspace too small: need %zu have %zu\n", off, ws_size); return; }

  static int grid_blocks = 0;
  if (!grid_blocks) {
    int dev = 0, cus = 0, per_cu = 0;
    hipGetDevice(&dev);
    hipDeviceGetAttribute(&cus, hipDeviceAttributeMultiprocessorCount, dev);
    hipOccupancyMaxActiveBlocksPerMultiprocessor(&per_cu, fwd_megakernel, 256, 0);
    if (per_cu > 2) per_cu = 2;
    if (per_cu < 1) per_cu = 1;
    grid_blocks = cus * per_cu;
  }
  (void)hipMemsetAsync((char*)d_ws + OFF_BAR, 0, SYNC_BYTES, stream);
  void* args[] = {&p};
  hipError_t e = hipLaunchCooperativeKernel((void*)fwd_megakernel, dim3(grid_blocks), dim3(256), args, 0, stream);
  if (e != hipSuccess) fprintf(stderr, "cooperative launch failed: %s (grid %d)\n", hipGetErrorString(e), grid_blocks);
}
```
